# Optimizing an MI355X kernel written in HIP

```python
import math
import jax, jax.numpy as jnp
from jax import lax
import numpy as np

D_MODEL = 1024
BATCH = 4
SEQ = 8192
DEPTH = 4

N_MIXERS = 2
N_ATTN_LAYERS = (DEPTH + 1) // 2
N_GMLP_LAYERS = DEPTH // 2
D_FF = 2816
DIFF_HEADS = 8
DIFF_HEAD_DIM = D_MODEL // DIFF_HEADS // 2
DIFF_V_DIM = 2 * DIFF_HEAD_DIM
DIFF_QK_WIDTH = DIFF_HEADS * 2 * DIFF_HEAD_DIM
DIFF_V_WIDTH = DIFF_HEADS * DIFF_V_DIM
Q_BLOCK = 128
GMLP_HALF = 2 * D_MODEL
GMLP_GROUPS = 8
GMLP_CHUNK = 128
RMS_EPS = 1e-6
LN_EPS = 1e-5

kernel_name = "hybrid_diffattn_chunked_sgu_macaron"


def _rmsnorm(x, g):
    xf = x.astype(jnp.float32)
    y = xf * lax.rsqrt(jnp.mean(xf * xf, axis=-1, keepdims=True) + RMS_EPS)
    return (y * g.astype(jnp.float32)).astype(x.dtype)


def _layernorm(x, g, b):
    xf = x.astype(jnp.float32)
    mu = jnp.mean(xf, axis=-1, keepdims=True)
    xc = xf - mu
    var = jnp.mean(xc * xc, axis=-1, keepdims=True)
    y = xc * lax.rsqrt(var + LN_EPS) * g.astype(jnp.float32) + b.astype(jnp.float32)
    return y.astype(x.dtype)


def _swiglu_ffn(x, w_gate_up, w_down):
    g, u = jnp.split(x @ w_gate_up, 2, axis=-1)
    return (jax.nn.silu(g) * u) @ w_down


def _lambda_init(layer_idx):
    return 0.8 - 0.6 * math.exp(-0.3 * layer_idx)


def _diff_attention(h, w_in, w_out, q_norm, k_norm, lq1, lk1, lq2, lk2, subln, lam_init):
    B, S, _ = h.shape
    H, d, dv = DIFF_HEADS, DIFF_HEAD_DIM, DIFF_V_DIM
    q, k, v = jnp.split(h @ w_in, [DIFF_QK_WIDTH, 2 * DIFF_QK_WIDTH], axis=-1)
    q = _rmsnorm(q.reshape(B, S, H, 2, d), q_norm) * (d ** -0.5)
    k = _rmsnorm(k.reshape(B, S, H, 2, d), k_norm)
    v = v.reshape(B, S, H, dv)
    lam = (jnp.exp(jnp.sum(lq1.astype(jnp.float32) * lk1.astype(jnp.float32)))
           - jnp.exp(jnp.sum(lq2.astype(jnp.float32) * lk2.astype(jnp.float32)))
           + lam_init)
    outs = []
    for i in range(S // Q_BLOCK):
        L = (i + 1) * Q_BLOCK
        q_blk = q[:, i * Q_BLOCK:L]
        s = jnp.einsum('bqhcd,bkhcd->bhcqk', q_blk, k[:, :L]).astype(jnp.float32)
        qpos = i * Q_BLOCK + jnp.arange(Q_BLOCK)
        kpos = jnp.arange(L)
        mask = kpos[None, :] <= qpos[:, None]
        p = jax.nn.softmax(jnp.where(mask, s, -jnp.inf), axis=-1)
        a = (p[:, :, 0] - lam * p[:, :, 1]).astype(v.dtype)
        outs.append(jnp.einsum('bhqk,bkhe->bqhe', a, v[:, :L]))
    o = jnp.concatenate(outs, axis=1)
    o = _rmsnorm(o, subln) * (1.0 - lam_init)
    return o.reshape(B, S, DIFF_V_WIDTH) @ w_out


def _chunked_sgu(h, w_in, b_in, ln_g, ln_b, w_s, b_s, w_out, b_out):
    B, S, _ = h.shape
    z = jax.nn.gelu(h @ w_in + b_in, approximate=False)
    u, v = jnp.split(z, 2, axis=-1)
    v = _layernorm(v, ln_g, ln_b)
    nc = S // GMLP_CHUNK
    gc = GMLP_HALF // GMLP_GROUPS
    v = v.reshape(B, nc, GMLP_CHUNK, GMLP_GROUPS, gc)
    causal = jnp.tril(jnp.ones((GMLP_CHUNK, GMLP_CHUNK), dtype=bool))
    w = jnp.where(causal, w_s, 0.0)
    s = jnp.einsum('gts,bnsgc->bntgc', w, v) + jnp.transpose(b_s)[None, None, :, :, None]
    gated = u * s.reshape(B, S, GMLP_HALF)
    return gated @ w_out + b_out


def setup_inputs(seed: int = 0) -> dict:
    key = jax.random.key(seed)
    ks = jax.random.split(key, 32)
    f32 = jnp.float32
    nrm = lambda k, shape, scale: jax.random.normal(k, shape, f32) * scale
    gain = lambda k, shape: 1.0 + 0.02 * jax.random.normal(k, shape, f32)
    NA, NG = N_ATTN_LAYERS, N_GMLP_LAYERS
    return {
        "x": jax.random.normal(ks[0], (BATCH, SEQ, D_MODEL), f32),
        "ffn1_norm": gain(ks[1], (DEPTH, D_MODEL)),
        "ffn1_w_gate_up": nrm(ks[2], (DEPTH, D_MODEL, 2 * D_FF), D_MODEL ** -0.5),
        "ffn1_w_down": nrm(ks[3], (DEPTH, D_FF, D_MODEL), D_FF ** -0.5),
        "mix_norm": gain(ks[4], (DEPTH, D_MODEL)),
        "ffn2_norm": gain(ks[5], (DEPTH, D_MODEL)),
        "ffn2_w_gate_up": nrm(ks[6], (DEPTH, D_MODEL, 2 * D_FF), D_MODEL ** -0.5),
        "ffn2_w_down": nrm(ks[7], (DEPTH, D_FF, D_MODEL), D_FF ** -0.5),
        "attn_w_in": nrm(ks[8], (NA, D_MODEL, 2 * DIFF_QK_WIDTH + DIFF_V_WIDTH), D_MODEL ** -0.5),
        "attn_w_out": nrm(ks[9], (NA, DIFF_V_WIDTH, D_MODEL), DIFF_V_WIDTH ** -0.5),
        "attn_q_norm": gain(ks[10], (NA, DIFF_HEAD_DIM)),
        "attn_k_norm": gain(ks[11], (NA, DIFF_HEAD_DIM)),
        "attn_lambda_q1": nrm(ks[12], (NA, DIFF_HEAD_DIM), 0.1),
        "attn_lambda_k1": nrm(ks[13], (NA, DIFF_HEAD_DIM), 0.1),
        "attn_lambda_q2": nrm(ks[14], (NA, DIFF_HEAD_DIM), 0.1),
        "attn_lambda_k2": nrm(ks[15], (NA, DIFF_HEAD_DIM), 0.1),
        "attn_subln": gain(ks[16], (NA, DIFF_V_DIM)),
        "gmlp_w_in": nrm(ks[17], (NG, D_MODEL, 2 * GMLP_HALF), D_MODEL ** -0.5),
        "gmlp_b_in": nrm(ks[18], (NG, 2 * GMLP_HALF), 0.02),
        "gmlp_ln_g": gain(ks[19], (NG, GMLP_HALF)),
        "gmlp_ln_b": nrm(ks[20], (NG, GMLP_HALF), 0.02),
        "gmlp_w_s": nrm(ks[21], (NG, GMLP_GROUPS, GMLP_CHUNK, GMLP_CHUNK), 0.5 * GMLP_CHUNK ** -0.5),
        "gmlp_b_s": gain(ks[22], (NG, GMLP_GROUPS, GMLP_CHUNK)),
        "gmlp_w_out": nrm(ks[23], (NG, GMLP_HALF, D_MODEL), GMLP_HALF ** -0.5),
        "gmlp_b_out": nrm(ks[24], (NG, D_MODEL), 0.02),
    }


def reference(x, ffn1_norm, ffn1_w_gate_up, ffn1_w_down, mix_norm, ffn2_norm, ffn2_w_gate_up,
              ffn2_w_down, attn_w_in, attn_w_out, attn_q_norm, attn_k_norm, attn_lambda_q1,
              attn_lambda_k1, attn_lambda_q2, attn_lambda_k2, attn_subln, gmlp_w_in, gmlp_b_in,
              gmlp_ln_g, gmlp_ln_b, gmlp_w_s, gmlp_b_s, gmlp_w_out, gmlp_b_out):
    for i in range(DEPTH):
        x = x + 0.5 * _swiglu_ffn(_rmsnorm(x, ffn1_norm[i]), ffn1_w_gate_up[i], ffn1_w_down[i])
        h = _rmsnorm(x, mix_norm[i])
        j = i // N_MIXERS
        if i % N_MIXERS == 0:
            x = x + _diff_attention(h, attn_w_in[j], attn_w_out[j], attn_q_norm[j], attn_k_norm[j],
                                    attn_lambda_q1[j], attn_lambda_k1[j], attn_lambda_q2[j],
                                    attn_lambda_k2[j], attn_subln[j], _lambda_init(i))
        else:
            x = x + _chunked_sgu(h, gmlp_w_in[j], gmlp_b_in[j], gmlp_ln_g[j], gmlp_ln_b[j],
                                 gmlp_w_s[j], gmlp_b_s[j], gmlp_w_out[j], gmlp_b_out[j])
        x = x + 0.5 * _swiglu_ffn(_rmsnorm(x, ffn2_norm[i]), ffn2_w_gate_up[i], ffn2_w_down[i])
    return x
```

```cpp
#include <hip/hip_runtime.h>
#include <hip/hip_cooperative_groups.h>
#include <cstdio>
#include <cstdint>
namespace cg = cooperative_groups;
__device__ __forceinline__ int ltid() { int t = threadIdx.x; asm volatile("" : "+v"(t)); return t; }
__device__ __forceinline__ int lbid() { int t = blockIdx.x; asm volatile("" : "+s"(t)); return t; }
__device__ __forceinline__ int lgrid() { int t = gridDim.x; asm volatile("" : "+s"(t)); return t; }
namespace pg8 {
#define PG8_LAS __attribute__((address_space(3)))
typedef unsigned short bf16_t;
typedef short bf16x8 __attribute__((ext_vector_type(8)));
typedef float f32x4 __attribute__((ext_vector_type(4)));
typedef unsigned u32x4 __attribute__((ext_vector_type(4)));
constexpr int BM = 256, BK = 64, HALF = 128, HTB = HALF * BK * 2  , STAGE_BYTES = 8 * HTB, NXCD = 8, WGM = 8;

__host__ __device__ __forceinline__ int lds_byte(int r, int c) { const int st = (r >> 4) * 2 + (c >> 5), rr = r & 15, cc = c & 31, ob = rr * 64 + cc * 2; return st * 1024 + (ob ^ (((ob >> 9) & 1) << 5)); }
__host__ __device__ __forceinline__ void stage_rc(int b, int& R, int& C) { const int st = b / 1024, sb = b % 1024, swz = sb ^ (((sb >> 9) & 1) << 5); R = (st >> 1) * 16 + swz / 64; C = (st & 1) * 32 + (swz % 64) / 2; }
__host__ __device__ __forceinline__ int perm32(int rho) { const int n = rho >> 4, i = rho & 15; return 8 * (i >> 2) + 4 * n + (i & 3); }

struct Unit { int pm, pn, ui; };
struct Gemm { const bf16_t* A; const bf16_t* Bt; int M, N, K, lda; size_t hstepA, gstrA; };

struct StaticOrder {
    int nM, nN, nwg, G, c;
    __host__ __device__ void init(int M, int N, int G_, int c_) { nM = M / BM; nN = N / BM; nwg = nM * nN; G = G_; c = c_; }
    __host__ __device__ bool next(int i, Unit& u) const {
        const long L = (long)i * G + c; if (L >= nwg) return false;
        int wgid = (int)L; { const int q = nwg / NXCD, r = nwg % NXCD, xcd = wgid % NXCD, off = wgid / NXCD; wgid = (xcd < r ? xcd * (q + 1) : r * (q + 1) + (xcd - r) * q) + off; }
        const int nig = WGM * nN, gid = wgid / nig, fm = gid * WGM, gsz = (nM - fm) < WGM ? (nM - fm) : WGM;
        u.pm = fm + ((wgid % nig) % gsz); u.pn = (wgid % nig) / gsz; u.ui = i; return true;
    }
    __device__ __forceinline__ void a_ready(const Unit&) const {}
    __device__ __forceinline__ void done(const Unit&) const {}
};
struct PairOrder {
    int nN2, p, m;
    __host__ __device__ void init(int M, int N, int G_, int c_) { nN2 = (N / BM) / 2; const int v = (G_ % 8 == 0) ? (c_ % 8) * (G_ / 8) + c_ / 8 : c_; p = v >> 1; m = v & 1; (void)M; }
    __device__ __forceinline__ bool next(int i, Unit& u) const { if (i >= nN2) return false; int pp = p; asm volatile("" : "+s"(pp));
        u.pm = pp; u.pn = m * nN2 + i; u.ui = i; return true; }
    __device__ __forceinline__ void a_ready(const Unit&) const {}
    __device__ __forceinline__ void done(const Unit&) const {}
};


__device__ __forceinline__ unsigned cvt_pk_bf16(float lo, float hi) { unsigned r; asm volatile("v_cvt_pk_bf16_f32 %0, %1, %2" : "=v"(r) : "v"(lo), "v"(hi)); return r; }
typedef float f32x2 __attribute__((ext_vector_type(2)));
__device__ __forceinline__ f32x2 gelu_pk(f32x2 v) {
    const f32x2 av = __builtin_elementwise_abs(v), d = av * 0.2316418882f + 1.0f;
    f32x2 t; t.x = __builtin_amdgcn_rcpf(d.x); t.y = __builtin_amdgcn_rcpf(d.y);
    f32x2 q = t * 0.5307027145f + (-0.7265760135f); q = q * t + 0.7107068705f; q = q * t + (-0.142248368f); q = q * t + 0.127414796f; q = q * t;
    const f32x2 s = (v * v) * (-0.72134752044f);
    f32x2 e; e.x = __builtin_amdgcn_exp2f(s.x); e.y = __builtin_amdgcn_exp2f(s.y);
    const f32x2 mx = (f32x2){__builtin_fmaxf(v.x, 0.f), __builtin_fmaxf(v.y, 0.f)};
    return mx - av * (q * e);
}
__device__ __forceinline__ float silu_f(float x) { return x * __builtin_amdgcn_rcpf(1.0f + __builtin_amdgcn_exp2f(-1.4426950408889634f * x)); }
__device__ __forceinline__ float dot4(f32x4 v) { return (v[0] * v[0] + v[1] * v[1]) + (v[2] * v[2] + v[3] * v[3]); }
__device__ __forceinline__ float sum4(f32x4 v) { return (v[0] + v[1]) + (v[2] + v[3]); }
__device__ __forceinline__ u32x4 pack8(f32x4 a, f32x4 b) { u32x4 w; w.x = cvt_pk_bf16(a[0], a[1]); w.y = cvt_pk_bf16(a[2], a[3]); w.z = cvt_pk_bf16(b[0], b[1]); w.w = cvt_pk_bf16(b[2], b[3]); return w; }

#ifndef EPI_WT
#define EPI_WT 0
#endif
__device__ __forceinline__ void st16(void* p, u32x4 v) {
#if EPI_WT
    asm volatile("global_store_dwordx4 %0, %1, off sc1\n\ts_nop 1" :: "v"(p), "v"(v) : "memory");
#else
    *(u32x4*)p = v;
#endif
}
struct EpiSwiglu {
    static constexpr bool PERM = true, AFTER_DRAIN = false, HAS_PREFETCH = false;
    bf16_t* O; const PG8_LAS float* rs; int ldo;
    __device__ __forceinline__ void operator()(const f32x4 (&acc)[2][2][4][2], const Unit& u, int wr, int wc, int fr, int fq) const {
        const int rl0 = wr * 64 + fr, col0 = u.pn * HALF + wc * 32 + 8 * fq;
#pragma unroll
        for (int ai = 0; ai < 2; ++ai)
#pragma unroll
            for (int m = 0; m < 4; ++m) { const int rl = rl0 + ai * HALF + m * 16; const float s = rs[u.ui * BM + rl];
                f32x4 h[2]; const float ns = -1.4426950408889634f * s, s2 = s * s;
#pragma unroll
                for (int n = 0; n < 2; ++n) { const f32x4 g = acc[ai][0][m][n], up = acc[ai][1][m][n]; const f32x4 ea = g * ns;
                    const f32x4 d = (f32x4){__builtin_amdgcn_exp2f(ea[0]), __builtin_amdgcn_exp2f(ea[1]), __builtin_amdgcn_exp2f(ea[2]), __builtin_amdgcn_exp2f(ea[3])} + 1.0f;
                    const f32x4 r = (f32x4){__builtin_amdgcn_rcpf(d[0]), __builtin_amdgcn_rcpf(d[1]), __builtin_amdgcn_rcpf(d[2]), __builtin_amdgcn_rcpf(d[3])};
                    h[n] = (g * up) * (r * s2); }
                st16(O + (size_t)(u.pm * BM + rl) * ldo + col0, pack8(h[0], h[1])); }
    }
};
#ifndef RESID_USE_LO
#define RESID_USE_LO 0
#endif
struct EpiResid {
    static constexpr bool PERM = true, AFTER_DRAIN = false, HAS_PREFETCH = false, LO = (RESID_USE_LO != 0);
    static constexpr int XBP_E = 1024;
    const float* xin; float* out; bf16_t* xb; float* part; const float* bias; float alpha; int mode;
    template <bool RD32, bool WR32> __device__ __forceinline__ void body(const f32x4 (&acc)[2][2][4][2], const Unit& u, int wr, int wc, int fr, int fq) const {
        const int rl0 = wr * 64 + fr, col0 = u.pn * BM + wc * 32 + 8 * fq;
        const size_t off0 = (size_t)(u.pm * BM + rl0) * 1024 + col0;
        const size_t off0x = (size_t)(u.pm * BM + rl0) * XBP_E + col0;
        constexpr int DEPTH = (RD32 || LO) ? 2 : 8;
        f32x4 pre[DEPTH][2][2];
#define RES_LOAD(slot, gi) do { const size_t o_ = off0 + (size_t)(((gi) >> 2) * HALF + ((gi) & 3) * 16) * 1024, ox_ = off0x + (size_t)(((gi) >> 2) * HALF + ((gi) & 3) * 16) * XBP_E; \
            if (RD32) { const float* p_ = xin + o_; pre[slot][0][0] = *(const f32x4*)(p_); pre[slot][0][1] = *(const f32x4*)(p_ + 4); pre[slot][1][0] = *(const f32x4*)(p_ + HALF); pre[slot][1][1] = *(const f32x4*)(p_ + HALF + 4); } \
            else { const bf16_t* h_ = xb + ox_; const float* l_ = out + o_; pre[slot][0][0] = *(const f32x4*)(h_); pre[slot][1][0] = *(const f32x4*)(h_ + HALF); if (LO) { pre[slot][0][1] = *(const f32x4*)(l_); pre[slot][1][1] = *(const f32x4*)(l_ + 4); } } } while (0)
#pragma unroll
        for (int gi = 0; gi < DEPTH; ++gi) RES_LOAD(gi, gi);
        f32x4 bv[2][2];
#pragma unroll
        for (int bj = 0; bj < 2; ++bj)
#pragma unroll
            for (int n = 0; n < 2; ++n) bv[bj][n] = bias ? *(const f32x4*)(bias + col0 + bj * HALF + 4 * n) * alpha : (f32x4){0.f, 0.f, 0.f, 0.f};
        asm volatile("" ::: "memory");
#pragma unroll
        for (int gi = 0; gi < 8; ++gi) { const int ai = gi >> 2, m = gi & 3; const int row = u.pm * BM + rl0 + ai * HALF + m * 16; const size_t off = (size_t)row * 1024 + col0, offx = (size_t)row * XBP_E + col0; float ss = 0.f;
            u32x4 lo_out[2];
#pragma unroll
            for (int bj = 0; bj < 2; ++bj) {
                f32x4 x0, x1;
                if (RD32) { x0 = pre[gi % DEPTH][bj][0]; x1 = pre[gi % DEPTH][bj][1]; }
                else { const u32x4 h = __builtin_bit_cast(u32x4, pre[gi % DEPTH][bj][0]);
                    x0 = (f32x4){__uint_as_float(h.x << 16), __uint_as_float(h.x & 0xffff0000u), __uint_as_float(h.y << 16), __uint_as_float(h.y & 0xffff0000u)};
                    x1 = (f32x4){__uint_as_float(h.z << 16), __uint_as_float(h.z & 0xffff0000u), __uint_as_float(h.w << 16), __uint_as_float(h.w & 0xffff0000u)};
                    if (LO) { const u32x4 l = __builtin_bit_cast(u32x4, pre[gi % DEPTH][bj][1]);
                        x0 = x0 + (f32x4){__uint_as_float(l.x << 16), __uint_as_float(l.x & 0xffff0000u), __uint_as_float(l.y << 16), __uint_as_float(l.y & 0xffff0000u)};
                        x1 = x1 + (f32x4){__uint_as_float(l.z << 16), __uint_as_float(l.z & 0xffff0000u), __uint_as_float(l.w << 16), __uint_as_float(l.w & 0xffff0000u)}; } }
                if (bias) { x0 = x0 + bv[bj][0]; x1 = x1 + bv[bj][1]; }
                const f32x4 v0 = x0 + acc[ai][bj][m][0] * alpha, v1 = x1 + acc[ai][bj][m][1] * alpha;
                ss += dot4(v0) + dot4(v1);
                if (WR32) { *(f32x4*)(out + off + bj * HALF) = v0; *(f32x4*)(out + off + bj * HALF + 4) = v1; }
                else { const u32x4 hn = pack8(v0, v1); st16(xb + offx + bj * HALF, hn);
                    const f32x4 r0 = v0 - (f32x4){__uint_as_float(hn.x << 16), __uint_as_float(hn.x & 0xffff0000u), __uint_as_float(hn.y << 16), __uint_as_float(hn.y & 0xffff0000u)};
                    const f32x4 r1 = v1 - (f32x4){__uint_as_float(hn.z << 16), __uint_as_float(hn.z & 0xffff0000u), __uint_as_float(hn.w << 16), __uint_as_float(hn.w & 0xffff0000u)};
                    lo_out[bj] = pack8(r0, r1); } }
            if (!WR32 && LO) { *(u32x4*)(out + off) = lo_out[0]; *(u32x4*)(out + off + 4) = lo_out[1]; }
            ss += __shfl_xor(ss, 16); ss += __shfl_xor(ss, 32);
            if (!WR32) { if (fq == 0) part[(size_t)row * 16 + u.pn * 4 + wc] = ss; }
            asm volatile("" ::: "memory");
            if (gi + DEPTH < 8) { RES_LOAD(gi % DEPTH, gi + DEPTH); asm volatile("" ::: "memory"); } }
#undef RES_LOAD
    }
    __device__ __forceinline__ void operator()(const f32x4 (&acc)[2][2][4][2], const Unit& u, int wr, int wc, int fr, int fq) const {
        if (mode == 1) body<true, false>(acc, u, wr, wc, fr, fq);
        else if (mode == 2) body<false, true>(acc, u, wr, wc, fr, fq);
        else body<false, false>(acc, u, wr, wc, fr, fq);
    }
};
struct EpiQKV {
    static constexpr bool PERM = true, AFTER_DRAIN = false, HAS_PREFETCH = false;
    bf16_t* O; const PG8_LAS float* rs; const PG8_LAS float* aux;
    __device__ __forceinline__ void operator()(const f32x4 (&acc)[2][2][4][2], const Unit& u, int wr, int wc, int fr, int fq) const {
        const int rl0 = wr * 64 + fr, kind = u.pn >> 2, colb = u.pn * BM + wc * 64 + 8 * fq;
        f32x4 gv[2][2]; const PG8_LAS float* gp = aux + (kind == 0 ? 0 : 64);
#pragma unroll
        for (int bj = 0; bj < 2; ++bj)
#pragma unroll
            for (int n = 0; n < 2; ++n) gv[bj][n] = *(const PG8_LAS f32x4*)(gp + 32 * bj + 8 * fq + 4 * n);
#pragma unroll
        for (int ai = 0; ai < 2; ++ai)
#pragma unroll
            for (int m = 0; m < 4; ++m) { const int rl = rl0 + ai * HALF + m * 16; const float s = rs[u.ui * BM + rl];
                f32x4 v[2][2]; float ss = 0.f;
#pragma unroll
                for (int bj = 0; bj < 2; ++bj)
#pragma unroll
                    for (int n = 0; n < 2; ++n) { v[bj][n] = acc[ai][bj][m][n] * s; ss += dot4(v[bj][n]); }
                if (kind < 2) { ss += __shfl_xor(ss, 16); ss += __shfl_xor(ss, 32); const float sc = rsqrtf(ss * (1.0f / 64.0f) + 1e-6f);
#pragma unroll
                    for (int bj = 0; bj < 2; ++bj)
#pragma unroll
                        for (int n = 0; n < 2; ++n) v[bj][n] = v[bj][n] * sc * gv[bj][n]; }
                bf16_t* p = O + (size_t)(u.pm * BM + rl) * 3072 + colb;
                *(u32x4*)(p) = pack8(v[0][0], v[0][1]); *(u32x4*)(p + 32) = pack8(v[1][0], v[1][1]); }
    }
};
struct EpiGmlpIn {
    static constexpr bool PERM = true, AFTER_DRAIN = false, HAS_PREFETCH = false;
    bf16_t* Z; const PG8_LAS float* rs; const PG8_LAS float* aux; float* stats;
    __device__ __forceinline__ void operator()(const f32x4 (&acc)[2][2][4][2], const Unit& u, int wr, int wc, int fr, int fq) const {
        const int rl0 = wr * 64 + fr, col0 = u.pn * BM + wc * 32 + 8 * fq; const bool isv = u.pn >= 8;
        f32x4 bv[2][2];
#pragma unroll
        for (int bj = 0; bj < 2; ++bj)
#pragma unroll
            for (int n = 0; n < 2; ++n) bv[bj][n] = *(const PG8_LAS f32x4*)(aux + u.ui * BM + wc * 32 + 8 * fq + bj * HALF + 4 * n);
#pragma unroll
        for (int ai = 0; ai < 2; ++ai)
#pragma unroll
            for (int m = 0; m < 4; ++m) { const int rl = rl0 + ai * HALF + m * 16; const float s = rs[u.ui * BM + rl]; const size_t row = (size_t)(u.pm * BM + rl);
                float sm = 0.f, sq = 0.f;
#pragma unroll
                for (int bj = 0; bj < 2; ++bj) { f32x4 v0 = acc[ai][bj][m][0] * s + bv[bj][0], v1 = acc[ai][bj][m][1] * s + bv[bj][1];
                    const f32x2 a = gelu_pk((f32x2){v0[0], v0[1]}), b = gelu_pk((f32x2){v0[2], v0[3]}), c = gelu_pk((f32x2){v1[0], v1[1]}), d = gelu_pk((f32x2){v1[2], v1[3]});
                    v0 = (f32x4){a.x, a.y, b.x, b.y}; v1 = (f32x4){c.x, c.y, d.x, d.y};
                    *(u32x4*)(Z + (isv ? (size_t)256 * 8 * 32768 : (size_t)0) + ((size_t)((2 * u.pm + ai) * 8 + (u.pn & 7)) * 128 + (rl & 127)) * 256 + wc * 32 + 8 * fq + bj * HALF) = pack8(v0, v1);
                    sm += sum4(v0) + sum4(v1); sq += dot4(v0) + dot4(v1); }
                if (isv) { sm += __shfl_xor(sm, 16); sm += __shfl_xor(sm, 32); sq += __shfl_xor(sq, 16); sq += __shfl_xor(sq, 32);
                    if (fq == 0) *(f32x2*)(stats + (row * 32 + (u.pn - 8) * 4 + wc) * 2) = (f32x2){sm, sq}; } }
    }
};
template <class Epi, class Sched, bool ALIGN_EPI = false, bool SP2 = false>
__device__ __forceinline__ void gemm_phase(PG8_LAS unsigned char* lds, const Gemm g, const Sched& S, const Epi& E) {
    const int tid = ltid(), wid = __builtin_amdgcn_readfirstlane(tid >> 6), lane = tid & 63, wr = wid >> 2, wc = wid & 3, fr = lane & 15, fq = lane >> 4;
    const int K = g.K, nt = K / BK;
    unsigned voffA[2], voffB[2];
#pragma unroll
    for (int i = 0; i < 2; ++i) { int R, C; stage_rc(tid * 16 + i * 8192, R, C); const int Rb = Epi::PERM ? ((R & ~31) + perm32(R & 31)) : R;
        voffA[i] = (unsigned)(R * g.lda + C) * 2u; voffB[i] = (unsigned)(Rb * K + C) * 2u; }
    const size_t kstep = (size_t)(BK * 2);
    const size_t hstep = (size_t)HALF * K * 2;
    const size_t tstep = 2 * hstep; const size_t hstepA = g.hstepA ? g.hstepA : (size_t)HALF * g.lda * 2, tstepA = 2 * hstepA;
    const unsigned ldsw = (unsigned)wid * 1024u;
    const int aoff = lds_byte(wr * 64 + fr, fq * 8), boff = lds_byte(wc * 32 + fr, fq * 8);
#define PG8_SA(b, h) (((b) * 2 + (h)) * HTB)
#define PG8_SB(b, h) ((4 + (b) * 2 + (h)) * HTB)
#define PG8_STAGE(bufoff, gbase, voff) do { _Pragma("unroll") for (int _i = 0; _i < 2; ++_i) \
        __builtin_amdgcn_global_load_lds((const unsigned*)((const char*)(gbase) + (voff)[_i]), (PG8_LAS unsigned*)(lds + (bufoff) + ldsw + _i * 8192), 16, 0, 0); } while (0)
#define PG8_LDA(dst, b, h) do { _Pragma("unroll") for (int m = 0; m < 4; ++m) _Pragma("unroll") for (int k = 0; k < 2; ++k) dst[m][k] = *(const PG8_LAS bf16x8*)(lds + PG8_SA(b, h) + aoff + m * 2048 + k * 1024); } while (0)
#define PG8_LDB(dst, b, h) do { _Pragma("unroll") for (int n = 0; n < 2; ++n) _Pragma("unroll") for (int k = 0; k < 2; ++k) dst[n][k] = *(const PG8_LAS bf16x8*)(lds + PG8_SB(b, h) + boff + n * 2048 + k * 1024); } while (0)
#define PG8_MMA(ai, bj, At, Bt) do { __builtin_amdgcn_s_setprio(1); _Pragma("unroll") for (int m = 0; m < 4; ++m) _Pragma("unroll") for (int n = 0; n < 2; ++n) _Pragma("unroll") for (int k = 0; k < 2; ++k) \
        acc[ai][bj][m][n] = __builtin_amdgcn_mfma_f32_16x16x32_bf16(Bt[n][k], At[m][k], acc[ai][bj][m][n], 0, 0, 0); __builtin_amdgcn_s_setprio(0); } while (0)
#define PG8_WAIT_V(n) asm volatile("s_waitcnt vmcnt(" #n ")" ::: "memory")
#define PG8_WAIT_L(n) asm volatile("s_waitcnt lgkmcnt(" #n ")" ::: "memory")
#define PG8_BAR __builtin_amdgcn_s_barrier()
#define PG8_SCHED __builtin_amdgcn_sched_barrier(0)
    Unit cur, nxt; int ui = 0;
    if (!S.next(0, cur)) return;
    f32x4 acc[2][2][4][2];
#pragma unroll
    for (int a = 0; a < 2; ++a)
#pragma unroll
        for (int b = 0; b < 2; ++b)
#pragma unroll
            for (int m = 0; m < 4; ++m)
#pragma unroll
                for (int n = 0; n < 2; ++n) acc[a][b][m][n] = (f32x4){0.f, 0.f, 0.f, 0.f};
    bf16x8 At[4][2], B0[2][2], B1[2][2];
    const char* cA = (const char*)g.A + (size_t)cur.pm * tstepA; const char* cB = (const char*)g.Bt + (size_t)cur.pn * tstep;
    S.a_ready(cur);
    if constexpr (SP2) {
        PG8_STAGE(PG8_SB(0, 0), cB, voffB); PG8_STAGE(PG8_SB(0, 1), cB + hstep, voffB); PG8_STAGE(PG8_SA(0, 0), cA, voffA); PG8_STAGE(PG8_SA(0, 1), cA + hstepA, voffA);
        if (wr == 1) PG8_BAR;
        PG8_WAIT_V(2); PG8_BAR;
        PG8_STAGE(PG8_SB(1, 0), cB + kstep, voffB); PG8_STAGE(PG8_SA(1, 0), cA + kstep, voffA); PG8_STAGE(PG8_SB(1, 1), cB + hstep + kstep, voffB);
        PG8_WAIT_V(6); PG8_BAR;
    } else {
        PG8_STAGE(PG8_SB(0, 0), cB, voffB); PG8_STAGE(PG8_SA(0, 0), cA, voffA); PG8_STAGE(PG8_SB(0, 1), cB + hstep, voffB); PG8_STAGE(PG8_SA(0, 1), cA + hstepA, voffA);
        if (wr == 1) PG8_BAR;
        PG8_WAIT_V(4); PG8_BAR;
        PG8_STAGE(PG8_SB(1, 0), cB + kstep, voffB); PG8_STAGE(PG8_SA(1, 0), cA + kstep, voffA); PG8_STAGE(PG8_SB(1, 1), cB + hstep + kstep, voffB);
        PG8_WAIT_V(6); PG8_BAR;
    }
    for (;;) {
        const bool has_next = S.next(ui + 1, nxt);
        const char* nA = has_next ? (const char*)g.A + (size_t)nxt.pm * tstepA : cA; const char* nB = has_next ? (const char*)g.Bt + (size_t)nxt.pn * tstep : cB;
        for (int t = 0; t < nt; t += 2) {
            const bool last = (t == nt - 2);
            const char* a1 = cA + (g.gstrA ? (size_t)(t >> 2) * g.gstrA + (size_t)(t & 3) * kstep : (size_t)t * kstep) + kstep;
            const char* a2 = last ? nA : cA + (g.gstrA ? (size_t)((t + 2) >> 2) * g.gstrA + (size_t)((t + 2) & 3) * kstep : (size_t)(t + 2) * kstep); const char* b2 = last ? nB : cB + (size_t)(t + 2) * kstep;
            const char* a3 = a2 + kstep; const char* b3 = b2 + kstep;
            if (last && has_next) S.a_ready(nxt);
            if constexpr (Epi::HAS_PREFETCH) { if (t == nt - 4) E.prefetch(cur, tid, wid); }
            if constexpr (SP2) {
            PG8_LDB(B0, 0, 0); PG8_LDB(B1, 0, 1); PG8_SCHED; PG8_LDA(At, 0, 0); PG8_STAGE(PG8_SA(1, 1), a1 + hstepA, voffA);
            PG8_WAIT_V(8); PG8_WAIT_L(0); PG8_BAR; PG8_MMA(0, 0, At, B0); PG8_MMA(0, 1, At, B1); PG8_BAR; PG8_SCHED;
            PG8_LDA(At, 0, 1); PG8_STAGE(PG8_SB(0, 0), b2, voffB); PG8_STAGE(PG8_SB(0, 1), b2 + hstep, voffB); PG8_STAGE(PG8_SA(0, 0), a2, voffA);
            PG8_WAIT_V(8); PG8_WAIT_L(0); PG8_BAR; PG8_MMA(1, 0, At, B0); PG8_MMA(1, 1, At, B1); PG8_BAR; PG8_SCHED;
            PG8_LDB(B0, 1, 0); PG8_LDB(B1, 1, 1); PG8_SCHED; PG8_LDA(At, 1, 0); PG8_STAGE(PG8_SA(0, 1), a2 + hstepA, voffA);
            PG8_WAIT_V(8); PG8_WAIT_L(0); PG8_BAR; PG8_MMA(0, 0, At, B0); PG8_MMA(0, 1, At, B1); PG8_BAR; PG8_SCHED;
            PG8_LDA(At, 1, 1); PG8_STAGE(PG8_SB(1, 0), b3, voffB); PG8_STAGE(PG8_SB(1, 1), b3 + hstep, voffB); PG8_STAGE(PG8_SA(1, 0), a3, voffA);
            PG8_WAIT_V(8); PG8_WAIT_L(0); PG8_BAR; PG8_MMA(1, 0, At, B0); PG8_MMA(1, 1, At, B1); PG8_BAR; PG8_SCHED;
            } else {
            PG8_LDB(B0, 0, 0); PG8_SCHED; PG8_LDA(At, 0, 0); PG8_STAGE(PG8_SA(1, 1), a1 + hstepA, voffA);
            PG8_WAIT_L(8); PG8_BAR; PG8_WAIT_L(0); PG8_MMA(0, 0, At, B0); PG8_BAR; PG8_SCHED;
            PG8_LDB(B1, 0, 1); PG8_STAGE(PG8_SB(0, 0), b2, voffB);
            PG8_BAR; PG8_WAIT_L(0); PG8_MMA(0, 1, At, B1); PG8_BAR;
            PG8_LDA(At, 0, 1); PG8_STAGE(PG8_SA(0, 0), a2, voffA);
            PG8_BAR; PG8_WAIT_L(0); PG8_MMA(1, 0, At, B0); PG8_BAR; PG8_SCHED;
            PG8_STAGE(PG8_SB(0, 1), b2 + hstep, voffB);
            PG8_WAIT_V(6); PG8_BAR; PG8_MMA(1, 1, At, B1); PG8_BAR;
            PG8_LDB(B0, 1, 0); PG8_SCHED; PG8_LDA(At, 1, 0); PG8_STAGE(PG8_SA(0, 1), a2 + hstepA, voffA);
            PG8_WAIT_L(8); PG8_BAR; PG8_WAIT_L(0); PG8_MMA(0, 0, At, B0); PG8_BAR; PG8_SCHED;
            PG8_LDB(B1, 1, 1); PG8_STAGE(PG8_SB(1, 0), b3, voffB);
            PG8_BAR; PG8_WAIT_L(0); PG8_MMA(0, 1, At, B1); PG8_BAR;
            PG8_LDA(At, 1, 1); PG8_STAGE(PG8_SA(1, 0), a3, voffA);
            PG8_BAR; PG8_WAIT_L(0); PG8_MMA(1, 0, At, B0); PG8_BAR; PG8_SCHED;
            PG8_STAGE(PG8_SB(1, 1), b3 + hstep, voffB);
            PG8_WAIT_V(6); PG8_BAR; PG8_MMA(1, 1, At, B1); PG8_BAR;
            }
        }
        if constexpr (ALIGN_EPI) { if (wr == 0) PG8_BAR; }
        if constexpr (!Epi::AFTER_DRAIN) { E(acc, cur, wr, wc, fr, fq); S.done(cur); }
        if (!has_next) break;
#pragma unroll
        for (int a = 0; a < 2; ++a)
#pragma unroll
            for (int b = 0; b < 2; ++b)
#pragma unroll
                for (int m = 0; m < 4; ++m)
#pragma unroll
                    for (int n = 0; n < 2; ++n) acc[a][b][m][n] = (f32x4){0.f, 0.f, 0.f, 0.f};
        cur = nxt; cA = nA; cB = nB; ++ui;
        if constexpr (ALIGN_EPI) { if (wr == 1) PG8_BAR; }
    }
    PG8_WAIT_V(0);
    if constexpr (!ALIGN_EPI) { if (wr == 0) PG8_BAR; }
    PG8_BAR;
    if constexpr (Epi::AFTER_DRAIN) { E.fused(acc, cur, wr, wc, fr, fq, lds, wid, lane); S.done(cur); }
#undef PG8_SA
#undef PG8_SB
#undef PG8_STAGE
#undef PG8_LDA
#undef PG8_LDB
#undef PG8_MMA
#undef PG8_WAIT_V
#undef PG8_WAIT_L
#undef PG8_BAR
#undef PG8_SCHED
}
}

#ifndef PG8_SP2
#define PG8_SP2 true
#endif
#include <hip/hip_bf16.h>
#include <cmath>
namespace attn_body {
using bf16=__hip_bfloat16;
using bf16x8=__attribute__((ext_vector_type(8)))short;
using s16x4=__attribute__((ext_vector_type(4)))short;
using f32x16=__attribute__((ext_vector_type(16)))float;
using u32x4=__attribute__((ext_vector_type(4)))unsigned;
constexpr int BATCH=4,NHEAD=8,SEQ=8192,D=64,DM=3072,OPITCH=1024;
constexpr int NW=8,QBLK=32,QB=QBLK*NW,KVBLK=64,NQB=SEQ/QB;
constexpr int ATTN_PITCH=DM, ATTN_UNIT_ROWS=QB;
__device__ __forceinline__ int crow(int r,int hi){return (r&3)+8*(r>>2)+4*hi;}
#define SBAR() __builtin_amdgcn_sched_barrier(0)
__device__ __forceinline__ void cmask(f32x16&p0,f32x16&p1,int jb,int qrel,int hi){
  const float NEG=-INFINITY; int kb=64*jb+4*hi;
  #pragma unroll
  for(int r=0;r<16;++r){int kv=kb+(r&3)+8*(r>>2); if(kv>qrel)p0[r]=NEG; if(kv+32>qrel)p1[r]=NEG;}
}

constexpr int NSLOT=3, SLOTB=8192;
constexpr int LDS_K=0, LDS_V=NSLOT*SLOTB, LDS_WS=2*NSLOT*SLOTB, LDS_TMP=LDS_WS+NW*64*4, LDS_STY=LDS_TMP+NW*8192, LDS_LAM=LDS_STY+NW*4096, LDS_BYTES=LDS_LAM+64;
constexpr float C2=0.125f*1.4426950408889634f;
__device__ __forceinline__ void glds16(const void*gsrc,unsigned lds_dst){unsigned keep;
  asm volatile("s_mov_b32 %0, m0\n\ts_mov_b32 m0, %2\n\ts_nop 0\n\tglobal_load_lds_dwordx4 %1, off\n\ts_mov_b32 m0, %0":"=&s"(keep):"v"(gsrc),"s"(lds_dst):"memory");}
__device__ __forceinline__ float max3f(float a,float b,float c){float r;asm("v_max3_f32 %0, %1, %2, %3":"=v"(r):"v"(a),"v"(b),"v"(c));return r;}
__device__ __forceinline__ float max2f(float a,float b){float r;asm("v_max_f32_e32 %0, %1, %2":"=v"(r):"v"(a),"v"(b));return r;}
__device__ __forceinline__ float fadd_s(float a,float b){float r;asm("v_add_f32_e32 %0, %1, %2":"=v"(r):"v"(a),"v"(b));return r;}
__device__ __forceinline__ float fsub_s(float a,float b){float r;asm("v_sub_f32_e32 %0, %1, %2":"=v"(r):"v"(a),"v"(b));return r;}
typedef float f32x2_t __attribute__((ext_vector_type(2))); typedef __bf16 bf16x2_t __attribute__((ext_vector_type(2)));
__device__ __forceinline__ unsigned cvtpk_s(float lo,float hi){f32x2_t v={lo,hi};bf16x2_t b=__builtin_convertvector(v,bf16x2_t);return __builtin_bit_cast(unsigned,b);}
#define WAIT_BAR(N) asm volatile("s_waitcnt vmcnt(" #N ") lgkmcnt(0)\n\ts_barrier":::"memory")

__device__ __forceinline__ void qkt(f32x16&p0,f32x16&p1,const char*Kslot,const bf16x8*qr,const f32x16&negm,int r32,int hi){
  const char*kb=Kslot+hi*1024+r32*16;
  #pragma unroll
  for(int d0=0;d0<4;++d0){
    const bf16x8 b0=*reinterpret_cast<const bf16x8*>(kb+d0*2048);
    const bf16x8 b1=*reinterpret_cast<const bf16x8*>(kb+d0*2048+512);
    if(d0==0){p0=__builtin_amdgcn_mfma_f32_32x32x16_bf16(b0,qr[0],negm,0,0,0);p1=__builtin_amdgcn_mfma_f32_32x32x16_bf16(b1,qr[0],negm,0,0,0);}
    else{p0=__builtin_amdgcn_mfma_f32_32x32x16_bf16(b0,qr[d0],p0,0,0,0);p1=__builtin_amdgcn_mfma_f32_32x32x16_bf16(b1,qr[d0],p1,0,0,0);}}
}
typedef __attribute__((address_space(3))) const char* lds_cptr;
typedef short v4i16_t __attribute__((ext_vector_type(4)));
__device__ __forceinline__ void kload8(bf16x8*kf,lds_cptr kp){
  kf[0]=*(const __attribute__((address_space(3))) bf16x8*)(kp);      kf[1]=*(const __attribute__((address_space(3))) bf16x8*)(kp+512);
  kf[2]=*(const __attribute__((address_space(3))) bf16x8*)(kp+2048); kf[3]=*(const __attribute__((address_space(3))) bf16x8*)(kp+2560);
  kf[4]=*(const __attribute__((address_space(3))) bf16x8*)(kp+4096); kf[5]=*(const __attribute__((address_space(3))) bf16x8*)(kp+4608);
  kf[6]=*(const __attribute__((address_space(3))) bf16x8*)(kp+6144); kf[7]=*(const __attribute__((address_space(3))) bf16x8*)(kp+6656);
}
__device__ __forceinline__ void kload2(bf16x8*kf,lds_cptr kp,int j){ kf[2*j]=*(const __attribute__((address_space(3))) bf16x8*)(kp+j*2048); kf[2*j+1]=*(const __attribute__((address_space(3))) bf16x8*)(kp+j*2048+512); }
__device__ __forceinline__ s16x4 vtr(lds_cptr p){ return __builtin_bit_cast(s16x4,__builtin_amdgcn_ds_read_tr16_b64_v4i16((__attribute__((address_space(3))) v4i16_t*)p)); }
__device__ __forceinline__ float rowmax(const f32x16&p0,const f32x16&p1){
  float a=max3f(p0[0],p0[1],p1[0]),b=max3f(p0[2],p0[3],p1[1]);a=max3f(a,p1[2],p1[3]);
  #pragma unroll
  for(int r=4;r<16;r+=4){a=max3f(a,p0[r],p0[r+1]);b=max3f(b,p0[r+2],p0[r+3]);a=max3f(a,p1[r],p1[r+1]);b=max3f(b,p1[r+2],p1[r+3]);}
  const float m=max2f(a,b);
  auto rr=__builtin_amdgcn_permlane32_swap(__float_as_uint(m),__float_as_uint(m),false,false);
  return max2f(__uint_as_float(rr[0]),__uint_as_float(rr[1]));
}
__device__ __forceinline__ void pv(f32x16*o,int vb,bf16x8 pa0,bf16x8 pa1,bf16x8 pa2,bf16x8 pa3){
  #pragma unroll
  for(int d0=0;d0<2;++d0){s16x4 lo[4],hi[4];
    #pragma unroll
    for(int ks=0;ks<4;++ks){
      asm volatile("ds_read_b64_tr_b16 %0,%1 offset:%c2":"=&v"(lo[ks]):"v"(vb),"i"(d0*4096+ks*1024):"memory");
      asm volatile("ds_read_b64_tr_b16 %0,%1 offset:%c2":"=&v"(hi[ks]):"v"(vb),"i"(d0*4096+ks*1024+512):"memory");}
    asm volatile("s_waitcnt lgkmcnt(0)":::"memory");SBAR();
    #define PK(k) (bf16x8){lo[k][0],lo[k][1],lo[k][2],lo[k][3],hi[k][0],hi[k][1],hi[k][2],hi[k][3]}
    o[d0]=__builtin_amdgcn_mfma_f32_32x32x16_bf16(pa0,PK(0),o[d0],0,0,0);
    o[d0]=__builtin_amdgcn_mfma_f32_32x32x16_bf16(pa1,PK(1),o[d0],0,0,0);
    o[d0]=__builtin_amdgcn_mfma_f32_32x32x16_bf16(pa2,PK(2),o[d0],0,0,0);
    o[d0]=__builtin_amdgcn_mfma_f32_32x32x16_bf16(pa3,PK(3),o[d0],0,0,0);
    #undef PK
  }
}

constexpr int ATTN_LDS_BYTES=LDS_BYTES;
struct AttnUnit { int bh; int qb; };
struct StaticOrder {
  int vcu, G;
  __device__ __forceinline__ explicit StaticOrder(int grid,int block):vcu((grid%8==0)?(block%8)*(grid/8)+block/8:block),G(grid){}
  __device__ __forceinline__ bool next(int i,AttnUnit&u)const{
    if(G==256){ if(i>=4)return false; const int s=vcu&7; u.bh=vcu>>3; u.qb=(i==0)?s:(i==1)?15-s:(i==2)?16+s:31-s; return true; }
    const int L=i*G+vcu; if(L>=BATCH*NHEAD*NQB)return false; u.bh=L/NQB; u.qb=NQB-1-(L%NQB); return true; }
};
struct DArgs { const float* in[25]; float* out; unsigned char* ws; int ph_lo, ph_hi; };
typedef const __attribute__((address_space(4))) DArgs* DArgsP;
__device__ __forceinline__ DArgsP dargs(){ DArgsP p=(DArgsP)__builtin_amdgcn_kernarg_segment_ptr(); asm volatile("":"+s"(p)); return p; }
constexpr int SLOTV=16384;
constexpr int AQ_WORD0=12288;
constexpr int L2_K=0, L2_V=NSLOT*SLOTB, L2_WS=L2_V+NSLOT*SLOTV, L2_TMP=L2_WS+NW*64*4, L2_LAM=L2_TMP+NW*8192, L2_BYTES=L2_LAM+64;
template<int DUMMY> __device__ __forceinline__ void attn_pass2(const bf16*Qh,const bf16*__restrict__ Kh,const bf16*__restrict__ Vh,const int q0,char*shm,f32x16 (&o)[4]){
  const int tid=ltid(),lane=tid&63,r32=lane&31,hi=lane>>5; const int wid=__builtin_amdgcn_readfirstlane(tid>>6);
  const bf16*Qw=Qh+(long)(q0+wid*QBLK)*DM;
  const unsigned lds0=(unsigned)(uintptr_t)shm;
  float*wsf=(float*)(shm+L2_WS)+wid*64;
  const bf16*ksrc=Kh+(long)lane*DM+wid*8;
  const bf16*vsrc=Vh+(long)(16*(wid&3)+(lane>>2))*DM+(wid>>2)*32+(lane&3)*8;
  const unsigned kdst=lds0+L2_K+wid*1024, vdst=lds0+L2_V+wid*1024;
  #define DMA_K(t,slot) glds16(ksrc+(long)(t)*KVBLK*DM,(unsigned)__builtin_amdgcn_readfirstlane(kdst+(slot)))
  #define DMA_V(t,slot) do{ glds16(vsrc+(long)(t)*KVBLK*DM,(unsigned)__builtin_amdgcn_readfirstlane(vdst+2*(slot))); glds16(vsrc+(long)(t)*KVBLK*DM+64,(unsigned)__builtin_amdgcn_readfirstlane(vdst+2*(slot)+8192)); }while(0)
  const char*Kbase=shm+L2_K; bf16x8 kf[8];
  const lds_cptr shm3=(lds_cptr)shm; const lds_cptr kp0=shm3+L2_K+hi*1024+r32*16; const lds_cptr vp0=shm3+L2_V+((lane>>4)&1)*32+(lane&3)*8+(4*hi+((lane&15)>>2))*64;
  const int NT=(q0+QB)/KVBLK;
  DMA_K(0,0);DMA_V(0,0);DMA_K(1,SLOTB);
  bf16x8 qr[4];
  #pragma unroll
  for(int d0=0;d0<4;++d0)qr[d0]=*reinterpret_cast<const bf16x8*>(&Qw[(long)r32*DM+d0*16+hi*8]);
  float l_reg=0.f;o[0]=f32x16{};o[1]=f32x16{};o[2]=f32x16{};o[3]=f32x16{};
  const f32x16 zero16=f32x16{};
  const int qrel=wid*QBLK+r32;
  #define CMASK(P0,P1,t) do{int jb_=(t)-(NT-4); if(jb_>=0)cmask(P0,P1,jb_,qrel,hi);}while(0)
  f32x16 pA0,pA1,pB0,pB1;
  int sl_prev=0,sl_cur=0,sl_next=SLOTB;
  #define ROT() do{sl_prev=sl_cur;sl_cur=sl_next;sl_next=(sl_next==(NSLOT-1)*SLOTB)?0:sl_next+SLOTB;}while(0)
  DMA_K(2,2*SLOTB);
  WAIT_BAR(4);
  qkt(pA0,pA1,Kbase,qr,zero16,r32,hi);CMASK(pA0,pA1,0);
  _Pragma("unroll") for(int r=0;r<16;++r){pA0[r]=__builtin_amdgcn_exp2f(pA0[r]);pA1[r]=__builtin_amdgcn_exp2f(pA1[r]);}
  WAIT_BAR(0);
  DMA_K(3,0);DMA_V(1,SLOTB);
  ROT();
  kload8(kf,kp0+sl_cur);
  WAIT_BAR(3);
  s16x4 vlo[8],vhi[8]; u32x4 pw0,pw1,pw2,pw3;
  #define PKW(P,B) cvtpk_s(P[B],P[B+1])
  #define PAF(k) __builtin_bit_cast(bf16x8,pw##k)
  #define VFR(i) (bf16x8){vlo[i][0],vlo[i][1],vlo[i][2],vlo[i][3],vhi[i][0],vhi[i][1],vhi[i][2],vhi[i][3]}
  #define PIN(x) asm volatile("":"+v"(x))
  #define GAPA(MF,A0,A1,A2,A3,W0,W1,PW) do{ MF; sacc+=A0; sacc+=A1; sacc+=A2; sacc+=A3; PIN(sacc); W0; W1; PIN(PW); SBAR(); }while(0)
  #define EX(v) __builtin_amdgcn_exp2f(v)
  #define GAPB(MF,X,B) do{ MF; X[B]=EX(X[B]); X[B+1]=EX(X[B+1]); PIN(X); SBAR(); }while(0)
  #define FOFF(d,ks) ((((d)>>1)*8192)+(((d)&1)*4096)+((ks)*1024))
  #define VRD(d,ks) do{ vlo[2*(d)+((ks)&1)]=vtr(vp_+FOFF(d,ks)); vhi[2*(d)+((ks)&1)]=vtr(vp_+(FOFF(d,ks)+512)); }while(0)
  #define VRH(d,ks) do{ VRD(d,ks); SBAR(); }while(0)
  #define VF(d,ks) VFR(2*(d)+((ks)&1))
  #define KRD(G,j) do{ if(G){ kload2(kf,kp0+sl_next,j); SBAR(); } }while(0)
  #define MF32(a,b,c) __builtin_amdgcn_mfma_f32_32x32x16_bf16(a,b,c,0,0,0)
  #define STEP(C0,C1,P0,P1,t,GK,GV,GL) do{ SBAR(); \
    const lds_cptr vp_=vp0+2*sl_prev; \
    VRD(0,0); SBAR(); float sacc=(P0[0]+P0[1]); \
    GAPA(C0=MF32(kf[0],qr[0],zero16), P0[2],P0[3],P0[4],P0[5],     pw0[0]=PKW(P0,0), pw0[1]=PKW(P0,2), pw0); \
    VRD(1,0); SBAR(); GAPA(C1=MF32(kf[1],qr[0],zero16), P0[6],P0[7],P0[8],P0[9],     pw0[2]=PKW(P0,4), pw0[3]=PKW(P0,6), pw0); \
    VRD(2,0); SBAR(); GAPA(C0=MF32(kf[2],qr[1],C0),   P0[10],P0[11],P0[12],P0[13], pw1[0]=PKW(P0,8), pw1[1]=PKW(P0,10), pw1); \
    VRD(3,0); SBAR(); GAPA(C1=MF32(kf[3],qr[1],C1),   P0[14],P0[15],P1[0],P1[1],   pw1[2]=PKW(P0,12),pw1[3]=PKW(P0,14), pw1); \
    VRD(0,1); SBAR(); GAPA(C0=MF32(kf[4],qr[2],C0),   P1[2],P1[3],P1[4],P1[5],     pw2[0]=PKW(P1,0), pw2[1]=PKW(P1,2), pw2); \
    VRD(1,1); SBAR(); GAPA(C1=MF32(kf[5],qr[2],C1),   P1[6],P1[7],P1[8],P1[9],     pw2[2]=PKW(P1,4), pw2[3]=PKW(P1,6), pw2); \
    VRD(2,1); SBAR(); GAPA(C0=MF32(kf[6],qr[3],C0),   P1[10],P1[11],P1[12],P1[13], pw3[0]=PKW(P1,8), pw3[1]=PKW(P1,10), pw3); \
    VRD(3,1); SBAR(); GAPA(C1=MF32(kf[7],qr[3],C1),   P1[14],P1[15],0.f,0.f,       pw3[2]=PKW(P1,12),pw3[3]=PKW(P1,14), pw3); \
    l_reg+=sacc; \
    if(GK){DMA_K((t)+3,sl_cur);} if(GV){DMA_V((t)+1,sl_next);} \
    CMASK(C0,C1,t); \
    SBAR(); \
    GAPB(o[0]=MF32(PAF(0),VF(0,0),o[0]), C0,0);  VRH(0,2); \
    GAPB(o[1]=MF32(PAF(0),VF(1,0),o[1]), C0,2);  VRH(1,2); \
    GAPB(o[2]=MF32(PAF(0),VF(2,0),o[2]), C0,4);  VRH(2,2); \
    GAPB(o[3]=MF32(PAF(0),VF(3,0),o[3]), C0,6);  VRH(3,2); \
    GAPB(o[0]=MF32(PAF(1),VF(0,1),o[0]), C0,8);  VRH(0,3); \
    GAPB(o[1]=MF32(PAF(1),VF(1,1),o[1]), C0,10); VRH(1,3); \
    GAPB(o[2]=MF32(PAF(1),VF(2,1),o[2]), C0,12); VRH(2,3); \
    GAPB(o[3]=MF32(PAF(1),VF(3,1),o[3]), C0,14); VRH(3,3); \
    GAPB(o[0]=MF32(PAF(2),VF(0,2),o[0]), C1,0); \
    GAPB(o[1]=MF32(PAF(2),VF(1,2),o[1]), C1,2); \
    KRD(GL,0); GAPB(o[2]=MF32(PAF(2),VF(2,2),o[2]), C1,4); \
    KRD(GL,1); GAPB(o[3]=MF32(PAF(2),VF(3,2),o[3]), C1,6); \
    KRD(GL,2); GAPB(o[0]=MF32(PAF(3),VF(0,3),o[0]), C1,8); \
    KRD(GL,3); GAPB(o[1]=MF32(PAF(3),VF(1,3),o[1]), C1,10); \
    GAPB(o[2]=MF32(PAF(3),VF(2,3),o[2]), C1,12); \
    GAPB(o[3]=MF32(PAF(3),VF(3,3),o[3]), C1,14); \
    }while(0)
  int t=1;
  #undef CMASK
  #define CMASK(P0,P1,t) do{}while(0)
  for(;t+5<NT;t+=2){
    STEP(pB0,pB1,pA0,pA1,t,true,true,true);     WAIT_BAR(3); ROT();
    STEP(pA0,pA1,pB0,pB1,t+1,true,true,true);   WAIT_BAR(3); ROT();
  }
  #undef CMASK
  #define CMASK(P0,P1,t) do{int jb_=(t)-(NT-4); if(jb_>=0)cmask(P0,P1,jb_,qrel,hi);}while(0)
  #define ENDW(tt) do{ if((tt)+3<NT){WAIT_BAR(3);} else if((tt)+2<NT){WAIT_BAR(2);} else {WAIT_BAR(0);} }while(0)
  for(;t+1<NT;t+=2){
    STEP(pB0,pB1,pA0,pA1,t,(t+3<NT),(t+1<NT),(t+1<NT));       ENDW(t);   ROT();
    STEP(pA0,pA1,pB0,pB1,t+1,(t+4<NT),(t+2<NT),(t+2<NT));     ENDW(t+1); ROT();
  }
  STEP(pB0,pB1,pA0,pA1,NT-1,false,false,false);
  { float sacc=pB0[0]+pB0[1]; _Pragma("unroll") for(int r=2;r<16;++r)sacc+=pB0[r]; _Pragma("unroll") for(int r=0;r<16;++r)sacc+=pB1[r]; l_reg+=sacc;
    pw0=(u32x4){PKW(pB0,0),PKW(pB0,2),PKW(pB0,4),PKW(pB0,6)};pw1=(u32x4){PKW(pB0,8),PKW(pB0,10),PKW(pB0,12),PKW(pB0,14)};pw2=(u32x4){PKW(pB1,0),PKW(pB1,2),PKW(pB1,4),PKW(pB1,6)};pw3=(u32x4){PKW(pB1,8),PKW(pB1,10),PKW(pB1,12),PKW(pB1,14)};
    SBAR();
    const lds_cptr vq=vp0+2*sl_cur;
    #pragma unroll
    for(int d0=0;d0<4;++d0){ bf16x8 vf[4];
      #pragma unroll
      for(int ks=0;ks<4;++ks){ const s16x4 lo=vtr(vq+(d0*4096+ks*1024)), h2=vtr(vq+(d0*4096+ks*1024+512)); vf[ks]=(bf16x8){lo[0],lo[1],lo[2],lo[3],h2[0],h2[1],h2[2],h2[3]}; }
      o[d0]=MF32(PAF(0),vf[0],o[d0]); o[d0]=MF32(PAF(1),vf[1],o[d0]); o[d0]=MF32(PAF(2),vf[2],o[d0]); o[d0]=MF32(PAF(3),vf[3],o[d0]); } }
  #undef PKW
  #undef PAF
  #undef VFR
  #undef PIN
  #undef GAPA
  #undef GAPB
  #undef EX
  #undef VRD
  #undef VRH
  #undef VF
  #undef FOFF
  #undef KRD
  #undef STEP
  #undef ENDW
  #undef MF32
  {auto rr=__builtin_amdgcn_permlane32_swap(__float_as_uint(l_reg),__float_as_uint(l_reg),false,false);l_reg=__uint_as_float(rr[0])+__uint_as_float(rr[1]);}
  if(hi==0)wsf[32+r32]=l_reg;asm volatile("s_waitcnt lgkmcnt(0)":::"memory");
  #pragma unroll
  for(int r=0;r<16;++r){const float rl=__builtin_amdgcn_rcpf(wsf[32+crow(r,hi)]); o[0][r]*=rl;o[1][r]*=rl;o[2][r]*=rl;o[3][r]*=rl;}
  asm volatile("s_waitcnt lgkmcnt(0)\n\ts_barrier":::"memory");
  #undef DMA_K
  #undef DMA_V
  #undef CMASK
  #undef ROT
}
template<int DUMMY> __device__ __forceinline__ void dattn_phase2(const int l,char*shm,const size_t ws_qkv,const size_t ws_o){
  { const int tid0=ltid(); const int lane=tid0&63; const int j=l>>1; DArgsP ap=dargs();
    float s1=ap->in[12][j*64+lane]*ap->in[13][j*64+lane], s2=ap->in[14][j*64+lane]*ap->in[15][j*64+lane];
    #pragma unroll
    for(int o_=1;o_<64;o_<<=1){s1+=__shfl_xor(s1,o_);s2+=__shfl_xor(s2,o_);}
    const float lam_init=0.8f-0.6f*expf(-0.3f*(float)l); const float lam=expf(s1)-expf(s2)+lam_init;
    if(tid0==0){ float*lw=(float*)(shm+L2_LAM); lw[0]=lam; lw[1]=1.0f-lam_init; }
    asm volatile("s_waitcnt lgkmcnt(0)\n\ts_barrier":::"memory"); }
  for(int it=0;;++it){
    const int tid=ltid(),lane=tid&63,r32=lane&31,hi=lane>>5; const int wid=__builtin_amdgcn_readfirstlane(tid>>6);
    const StaticOrder S(lgrid(),lbid()); AttnUnit u; if(!S.next(it>>1,u))break;
    const int c=it&1; const int b=u.bh/NHEAD,h=u.bh%NHEAD; const int q0=u.qb*QB;
    unsigned*tmpw=(unsigned*)(shm+L2_TMP)+wid*2048; bf16*stg=(bf16*)tmpw;
    f32x16 o[4];
    { DArgsP ap=dargs(); const bf16*base=(const bf16*)(ap->ws+ws_qkv)+(long)b*SEQ*DM;
      attn_pass2<0>(base+h*128+c*64,base+1024+h*128+c*64,base+2048+h*128,q0,shm,o); }
    if(c==0){
      #pragma unroll
      for(int d=0;d<4;++d){
        #pragma unroll
        for(int r=0;r<16;r+=2)tmpw[(d*8+(r>>1))*64+lane]=cvtpk_s(o[d][r],o[d][r+1]);}
    }else{
      unsigned t[32];
      #pragma unroll
      for(int k=0;k<32;++k)t[k]=tmpw[k*64+lane];
      const float lam=*((const float*)(shm+L2_LAM));
      asm volatile("s_waitcnt lgkmcnt(0)":::"memory");
      #pragma unroll
      for(int r=0;r<16;r+=2){const int orow0=crow(r,hi),orow1=crow(r+1,hi);
        #pragma unroll
        for(int d=0;d<4;++d){ const unsigned w=t[d*8+(r>>1)];
          stg[orow0*128+d*32+r32]=__float2bfloat16(__uint_as_float(w<<16)-lam*o[d][r]);
          stg[orow1*128+d*32+r32]=__float2bfloat16(__uint_as_float(w&0xffff0000u)-lam*o[d][r+1]);}}
      asm volatile("s_waitcnt lgkmcnt(0)":::"memory");
      DArgsP ap=dargs(); const int j=l>>1; const float osc=*((const float*)(shm+L2_LAM+4));
      const int ch=lane&15; const float*subln=ap->in[16]+j*128;
      float gn[8];
      #pragma unroll
      for(int k=0;k<8;++k)gn[k]=subln[ch*8+k]*osc;
      bf16*Ow=(bf16*)(ap->ws+ws_o)+((long)b*SEQ+q0+wid*QBLK)*OPITCH+h*128+ch*8;
      #pragma unroll
      for(int i=0;i<8;++i){const int row=i*4+(lane>>4);
        const u32x4 v=*(const u32x4*)(stg+row*128+ch*8);
        float f[8]; f[0]=__uint_as_float(v.x<<16);f[1]=__uint_as_float(v.x&0xffff0000u);f[2]=__uint_as_float(v.y<<16);f[3]=__uint_as_float(v.y&0xffff0000u);
        f[4]=__uint_as_float(v.z<<16);f[5]=__uint_as_float(v.z&0xffff0000u);f[6]=__uint_as_float(v.w<<16);f[7]=__uint_as_float(v.w&0xffff0000u);
        float ss=0.f;
        #pragma unroll
        for(int k=0;k<8;++k)ss+=f[k]*f[k];
        ss+=__shfl_xor(ss,1);ss+=__shfl_xor(ss,2);ss+=__shfl_xor(ss,4);ss+=__shfl_xor(ss,8);
        const float rstd=rsqrtf(ss*(1.0f/128.0f)+1e-6f);
        u32x4 w; w.x=cvtpk_s(f[0]*rstd*gn[0],f[1]*rstd*gn[1]); w.y=cvtpk_s(f[2]*rstd*gn[2],f[3]*rstd*gn[3]); w.z=cvtpk_s(f[4]*rstd*gn[4],f[5]*rstd*gn[5]); w.w=cvtpk_s(f[6]*rstd*gn[6],f[7]*rstd*gn[7]);
        *(u32x4*)(Ow+(long)row*OPITCH)=w; }
    }
    asm volatile("s_waitcnt lgkmcnt(0)":::"memory");
  }
}

#undef SBAR
#undef WAIT_BAR
}
#define GAS __attribute__((address_space(1)))
#define LAS __attribute__((address_space(3)))
typedef unsigned short bf16;
typedef unsigned v4u __attribute__((ext_vector_type(4)));
typedef unsigned v2u __attribute__((ext_vector_type(2)));
typedef float f32x4 __attribute__((ext_vector_type(4)));
typedef float f32x2 __attribute__((ext_vector_type(2)));
typedef short bf16x8 __attribute__((ext_vector_type(8)));
constexpr int NWAVES = 8;
constexpr int BATCH = 4, SEQ = 8192, D = 1024, M = BATCH * SEQ, DFF = 2816, DEPTH = 4, GH = 2048;
constexpr size_t MiB = 1u << 20;
constexpr size_t WS_WSB = 1 * MiB, WS_PART = 2 * MiB, WS_STATS = 4 * MiB, WS_WFFN = 12 * MiB, WS_WMIX = 144 * MiB, WS_XB = 184 * MiB, WS_ACT = 256 * MiB, WS_O = 448 * MiB, WS_END = 512 * MiB;
constexpr size_t FFN_STRIDE = 16 * MiB + MiB / 2, FFN_DOWN_OFF = 11 * MiB;
#define MIX_OFF(l) ((size_t)((l) >> 1) * (20 * MiB) + (size_t)((l) & 1) * (8 * MiB))
constexpr int XBP = 1024;
static_assert(WS_XB + (size_t)32768 * XBP * 2 <= 256 * MiB && WS_WMIX + 40 * MiB <= WS_XB, "d_ws map (XB)");
constexpr int RING_BYTES = 131072, RS_OFF = RING_BYTES, RS_BYTES = 16 * 1024, LDS_BYTES = 150528;
static_assert(attn_body::L2_BYTES <= LDS_BYTES && RS_OFF + RS_BYTES <= LDS_BYTES, "LDS map");
constexpr int NPHASE = 1 + 7 * DEPTH;
constexpr size_t ZV_OFF = (size_t)256 * 8 * 32768;

__device__ __forceinline__ float wave_sum(float v) {
#pragma unroll
    for (int o = 1; o < 64; o <<= 1) v += __shfl_xor(v, o);
    return v;
}
__device__ __forceinline__ unsigned f2bf(float f) { unsigned u = __builtin_bit_cast(unsigned, f); return (u + 0x7fffu + ((u >> 16) & 1u)) >> 16; }
__device__ __forceinline__ unsigned pk2(float lo, float hi) { return pg8::cvt_pk_bf16(lo, hi); }
__device__ __forceinline__ float bflo(unsigned w) { return __uint_as_float(w << 16); }
__device__ __forceinline__ float bfhi(unsigned w) { return __uint_as_float(w & 0xffff0000u); }

template <int MODE> __device__ __forceinline__ int map_row(int n) {
    if (MODE == 1) { const int up = n >= DFF ? 1 : 0; const int f = n - up * DFF; return (f >> 7) * 256 + up * 128 + (f & 127); }
    if (MODE == 2) { const int t = n & 255; return (n & ~255) + ((t >> 5) & 1) * 128 + (t >> 6) * 32 + (t & 31); }
    return n;
}
template <int MODE> __device__ __forceinline__ void transpose_item(const float* W, int K, int N, bf16* WT, const float* gain, LAS float* scr, int item, int lane) {
    const int nblk = N / 32, kb = item / nblk, nb = item % nblk, k0 = 64 * kb, n0 = 32 * nb;
    float wv[32];
#pragma unroll
    for (int i = 0; i < 32; ++i) { const int kk = 2 * i + (lane >> 5); wv[i] = W[(size_t)(k0 + kk) * N + n0 + (lane & 31)]; }
    const float gl = gain ? gain[k0 + lane] : 1.0f;
#pragma unroll
    for (int i = 0; i < 32; ++i) { const int kk = 2 * i + (lane >> 5); scr[kk * 33 + (lane & 31)] = wv[i] * __shfl(gl, kk); }
    asm volatile("s_waitcnt lgkmcnt(0)" ::: "memory");
    const int c = lane & 7;
#pragma unroll
    for (int j = 0; j < 4; ++j) { const int n = (lane >> 3) + 8 * j; const LAS float* s = scr + (8 * c) * 33 + n;
        v4u o; o.x = pk2(s[0 * 33], s[1 * 33]); o.y = pk2(s[2 * 33], s[3 * 33]); o.z = pk2(s[4 * 33], s[5 * 33]); o.w = pk2(s[6 * 33], s[7 * 33]);
        *(v4u*)(WT + (size_t)map_row<MODE>(n0 + n) * K + k0 + 8 * c) = o; }
    asm volatile("s_waitcnt lgkmcnt(0)" ::: "memory");
}
template <int MODE> __device__ __forceinline__ void transpose_job(const float* W, int K, int N, bf16* WT, const float* gain, LAS float* scr, int lane, int gw, int NGW, int& cum) {
    const int nitems = (K / 64) * (N / 32);
    int first = (gw - (cum % NGW)); if (first < 0) first += NGW;
    for (int it = first; it < nitems; it += NGW) transpose_item<MODE>(W, K, N, WT, gain, scr, it, lane);
    cum += nitems;
}

struct Args { const float* in[25]; float* out; unsigned char* ws; int ph_lo, ph_hi; };

typedef const __attribute__((address_space(4))) Args* ArgsP;
__device__ __forceinline__ void prologue(ArgsP ap, LAS unsigned char* lds, int wave, int lane, int vcu, int G) {
    LAS float* scr = (LAS float*)(lds + wave * 16384);
    const int gw = vcu * NWAVES + wave, NGW = G * NWAVES;
    unsigned char* ws = ap->ws; int cum = 0;
    for (int l = 0; l < DEPTH; ++l) {
        for (int f = 0; f < 2; ++f) {
            const float* nrm = (f ? ap->in[5] : ap->in[1]) + (size_t)l * D; const float* wgu = (f ? ap->in[6] : ap->in[2]) + (size_t)l * D * 2 * DFF; const float* wd = (f ? ap->in[7] : ap->in[3]) + (size_t)l * DFF * D;
            bf16* dst = (bf16*)(ws + WS_WFFN + (size_t)(l * 2 + f) * FFN_STRIDE);
            transpose_job<1>(wgu, D, 2 * DFF, dst, nrm, scr, lane, gw, NGW, cum);
            transpose_job<0>(wd, DFF, D, (bf16*)((unsigned char*)dst + FFN_DOWN_OFF), nullptr, scr, lane, gw, NGW, cum);
        }
        const int j = l >> 1; bf16* mdst = (bf16*)(ws + WS_WMIX + MIX_OFF(l)); const float* mn = ap->in[4] + (size_t)l * D;
        if ((l & 1) == 0) {
            transpose_job<2>(ap->in[8] + (size_t)j * D * 3072, D, 3072, mdst, mn, scr, lane, gw, NGW, cum);
            transpose_job<0>(ap->in[9] + (size_t)j * D * D, D, D, (bf16*)((unsigned char*)mdst + 6 * MiB), nullptr, scr, lane, gw, NGW, cum);
        } else {
            transpose_job<0>(ap->in[17] + (size_t)j * D * 4096, D, 4096, mdst, mn, scr, lane, gw, NGW, cum);
            transpose_job<0>(ap->in[23] + (size_t)j * GH * D, GH, D, (bf16*)((unsigned char*)mdst + 8 * MiB), nullptr, scr, lane, gw, NGW, cum);
        }
    }
    { const float* wsrc = ap->in[21]; bf16* wdst = (bf16*)(ws + WS_WSB); const int gt = gw * 64 + lane, NT = NGW * 64;
      for (int i = gt; i < 2 * 8 * 128 * 128; i += NT) { const int s = i & 127, t = (i >> 7) & 127; wdst[i] = (bf16)f2bf(s <= t ? wsrc[i] : 0.0f); } }
    { const float* x = ap->in[0]; bf16* xb = (bf16*)(ws + WS_XB); float* part = (float*)(ws + WS_PART);
      for (int m0 = gw; m0 < M; m0 += 2 * NGW) {
          const int m1 = m0 + NGW; const f32x4* xr0 = (const f32x4*)(x + (size_t)m0 * D) + lane; const f32x4* xr1 = (const f32x4*)(x + (size_t)m1 * D) + lane; f32x4 v0[4], v1[4]; float s0 = 0.f, s1 = 0.f;
#pragma unroll
          for (int j = 0; j < 4; ++j) { v0[j] = xr0[64 * j]; v1[j] = xr1[64 * j]; }
#pragma unroll
          for (int j = 0; j < 4; ++j) { s0 += (v0[j][0] * v0[j][0] + v0[j][1] * v0[j][1]) + (v0[j][2] * v0[j][2] + v0[j][3] * v0[j][3]); s1 += (v1[j][0] * v1[j][0] + v1[j][1] * v1[j][1]) + (v1[j][2] * v1[j][2] + v1[j][3] * v1[j][3]); }
#pragma unroll
          for (int o = 1; o < 64; o <<= 1) { s0 += __shfl_xor(s0, o); s1 += __shfl_xor(s1, o); }
          v2u* o80 = (v2u*)(xb + (size_t)m0 * XBP) + lane; v2u* o81 = (v2u*)(xb + (size_t)m1 * XBP) + lane;
#pragma unroll
          for (int j = 0; j < 4; ++j) { o80[64 * j] = (v2u){pk2(v0[j][0], v0[j][1]), pk2(v0[j][2], v0[j][3])}; o81[64 * j] = (v2u){pk2(v1[j][0], v1[j][1]), pk2(v1[j][2], v1[j][3])}; }
          if (lane < 16) { part[(size_t)m0 * 16 + lane] = lane == 0 ? s0 : 0.f; part[(size_t)m1 * 16 + lane] = lane == 0 ? s1 : 0.f; } } }
}

__device__ __forceinline__ void fill_rs(LAS float* rs, const float* part, const pg8::StaticOrder& S, int tid, LAS float* aux = nullptr, const float* bias = nullptr, const float* qg = nullptr, const float* kg = nullptr, float qscale = 1.f) {
    pg8::Unit u;
    if (qg) { if (tid < 64) aux[tid] = qg[tid] * qscale; else if (tid < 128) aux[tid] = kg[tid - 64]; }
    for (int i0 = 0; ; i0 += 2) { const int i = i0 + (tid >> 8);
        if (!S.next(i0, u)) break;
        if (S.next(i, u)) { const int row = u.pm * 256 + (tid & 255); const f32x4* p = (const f32x4*)(part + (size_t)row * 16); const f32x4 a = p[0], b = p[1], c = p[2], d = p[3];
            const float s = (((a[0] + a[1]) + (a[2] + a[3])) + ((b[0] + b[1]) + (b[2] + b[3]))) + (((c[0] + c[1]) + (c[2] + c[3])) + ((d[0] + d[1]) + (d[2] + d[3])));
            rs[i * 256 + (tid & 255)] = rsqrtf(s * (1.0f / 1024.0f) + 1e-6f);
            if (bias) aux[i * 256 + (tid & 255)] = bias[u.pn * 256 + (tid & 255)]; } }
    __syncthreads();
}

__device__ __forceinline__ void sgu_phase(LAS unsigned char* lds, bf16* Z, const float* stats, const bf16* wsb, const float* lng, const float* lnb, const float* bs, int G, int c) {
    const int tid = ltid(), lane = tid & 63, wid = __builtin_amdgcn_readfirstlane(tid >> 6), wr = wid >> 2, wc = wid & 3, fr = lane & 15, fq = lane >> 4;
    LAS bf16* VT = (LAS bf16*)lds;
    LAS bf16* WL = (LAS bf16*)(lds + 69632);
    LAS float* MR = (LAS float*)(lds + 69632 + 34816);
    LAS float* GB = (LAS float*)(lds + 69632 + 34816 + 1024);
    for (int ck = c; ck < 256; ck += G) {
        const size_t row0 = (size_t)ck * 128;
        { const f32x4* sp = (const f32x4*)(stats + (row0 + (tid >> 2)) * 64) + (tid & 3) * 4; float s = 0.f, q = 0.f;
#pragma unroll
          for (int j = 0; j < 4; ++j) { const f32x4 v = sp[j]; s += v[0] + v[2]; q += v[1] + v[3]; }
          s += __shfl_xor(s, 1); s += __shfl_xor(s, 2); q += __shfl_xor(q, 1); q += __shfl_xor(q, 2);
          if ((tid & 3) == 0) { const float mean = s * (1.0f / 2048.0f); const float var = fmaxf(q * (1.0f / 2048.0f) - mean * mean, 0.f); MR[(tid >> 2) * 2] = mean; MR[(tid >> 2) * 2 + 1] = rsqrtf(var + 1e-5f); } }
        v4u vraw[8];
        const bf16* vb = Z + ZV_OFF + (size_t)ck * 8 * 32768 + (tid & 127) * 256 + (tid >> 7) * 8;
#define SGU_LOADVW(g_) do { _Pragma("unroll") for (int j = 0; j < 8; ++j) vraw[j] = *(const v4u*)(vb + (size_t)(g_) * 32768 + j * 32); } while (0)
        SGU_LOADVW(0);
        for (int g = 0; g < 8; ++g) {
            GB[tid] = tid < 256 ? lng[g * 256 + tid] : lnb[g * 256 + tid - 256];
            __syncthreads();
#pragma unroll
            for (int j = 0; j < 4; ++j) { const int p = tid + 512 * j, t = p >> 4, pc = p & 15; *(LAS v4u*)(WL + t * 136 + pc * 8) = *(const v4u*)(wsb + (size_t)g * 16384 + t * 128 + pc * 8); }
#pragma unroll
            for (int j = 0; j < 8; ++j) { const int s = tid & 127, cc = (tid >> 7) * 8 + 32 * j; const v4u raw = vraw[j];
                const float mean = MR[2 * s], rstd = MR[2 * s + 1];
                const f32x4 g0 = *(const LAS f32x4*)(GB + cc), g1 = *(const LAS f32x4*)(GB + cc + 4), b0 = *(const LAS f32x4*)(GB + 256 + cc), b1 = *(const LAS f32x4*)(GB + 256 + cc + 4);
                LAS bf16* d = VT + cc * 136 + s;
                d[0 * 136] = (bf16)f2bf((bflo(raw.x) - mean) * rstd * g0[0] + b0[0]); d[1 * 136] = (bf16)f2bf((bfhi(raw.x) - mean) * rstd * g0[1] + b0[1]);
                d[2 * 136] = (bf16)f2bf((bflo(raw.y) - mean) * rstd * g0[2] + b0[2]); d[3 * 136] = (bf16)f2bf((bfhi(raw.y) - mean) * rstd * g0[3] + b0[3]);
                d[4 * 136] = (bf16)f2bf((bflo(raw.z) - mean) * rstd * g1[0] + b1[0]); d[5 * 136] = (bf16)f2bf((bfhi(raw.z) - mean) * rstd * g1[1] + b1[1]);
                d[6 * 136] = (bf16)f2bf((bflo(raw.w) - mean) * rstd * g1[2] + b1[2]); d[7 * 136] = (bf16)f2bf((bfhi(raw.w) - mean) * rstd * g1[3] + b1[3]); }
            __syncthreads();
            v2u uu[4][4];
#pragma unroll
            for (int m = 0; m < 4; ++m) { const bf16* zr = Z + ((size_t)ck * 8 + g) * 32768 + (64 * wr + 16 * m + fr) * 256 + 64 * wc + 4 * fq;
#pragma unroll
                for (int n = 0; n < 4; ++n) uu[m][n] = *(const v2u*)(zr + 16 * n); }
            asm volatile("" ::: "memory");
            if (g < 7) SGU_LOADVW(g + 1);
            asm volatile("" ::: "memory");
            f32x4 acc[4][4];
#pragma unroll
            for (int m = 0; m < 4; ++m)
#pragma unroll
                for (int n = 0; n < 4; ++n) acc[m][n] = (f32x4){0.f, 0.f, 0.f, 0.f};
            const int kend = wr == 0 ? 2 : 4;
            for (int ks = 0; ks < kend; ++ks) { bf16x8 af[4], bfr[4];
#pragma unroll
                for (int m = 0; m < 4; ++m) af[m] = *(const LAS bf16x8*)(WL + (64 * wr + 16 * m + fr) * 136 + ks * 32 + fq * 8);
#pragma unroll
                for (int n = 0; n < 4; ++n) bfr[n] = *(const LAS bf16x8*)(VT + (64 * wc + 16 * n + fr) * 136 + ks * 32 + fq * 8);
#pragma unroll
                for (int m = 0; m < 4; ++m)
#pragma unroll
                    for (int n = 0; n < 4; ++n) acc[m][n] = __builtin_amdgcn_mfma_f32_16x16x32_bf16(bfr[n], af[m], acc[m][n], 0, 0, 0); }
#pragma unroll
            for (int m = 0; m < 4; ++m) { const int t = 64 * wr + 16 * m + fr; const float bsv = bs[g * 128 + t]; bf16* zr = Z + ((size_t)ck * 8 + g) * 32768 + t * 256 + 64 * wc + 4 * fq;
#pragma unroll
                for (int n = 0; n < 4; ++n) { const v2u u2 = uu[m][n]; const f32x4 a = acc[m][n];
                    *(v2u*)(zr + 16 * n) = (v2u){pk2(bflo(u2.x) * (a[0] + bsv), bfhi(u2.x) * (a[1] + bsv)), pk2(bflo(u2.y) * (a[2] + bsv), bfhi(u2.y) * (a[3] + bsv))}; } }
            __syncthreads();
        }
#undef SGU_LOADVW
    }
}

#define RLX_AGENT __ATOMIC_RELAXED, __HIP_MEMORY_SCOPE_AGENT
constexpr int MISC_OFF = 149632;
static_assert(attn_body::L2_BYTES <= MISC_OFF && MISC_OFF + 16 <= LDS_BYTES, "LDS map (barrier words)");
constexpr size_t WS_CTL = 0, CTL_ZERO_BYTES = 65536;
#define XB_TMO      128
#define XB_XCNT(j)  (256  + 64 * (j))
#define XB_XSUB(j)  (1280 + 64 * (j))
#define XB_XGEN(j)  (2304 + 64 * (j))
#define XB_TOP      3328
#define XB_TOPGEN   3392
#define XCD_BAR_WORDS 3456
#define XB_SPIN_CAP (1u << 18)

__device__ __forceinline__ unsigned xb_ld(unsigned* p)              { return __hip_atomic_load(p, __ATOMIC_RELAXED, __HIP_MEMORY_SCOPE_AGENT); }
__device__ __forceinline__ unsigned xb_add(unsigned* p, unsigned v) { return __hip_atomic_fetch_add(p, v, __ATOMIC_RELAXED, __HIP_MEMORY_SCOPE_AGENT); }
__device__ __forceinline__ unsigned xb_xcc_id() { return (unsigned)__builtin_amdgcn_s_getreg((3 << 11) | 20) & 0xFu; }
#define XB_SPIN(cond, bar) do { unsigned _sp = 0; while (cond) { __builtin_amdgcn_s_sleep(1); \
    if ((++_sp & 255u) == 0u) { if (xb_ld(&(bar)[XB_TMO])) break; if (_sp > XB_SPIN_CAP) { atomicAdd(&(bar)[XB_TMO], 1u); break; } } } } while (0)

struct XcdBarrier {
    unsigned* bar; unsigned x;
    volatile LAS unsigned* st;
};

__device__ __forceinline__ XcdBarrier xcd_barrier_post(unsigned* bar, volatile LAS unsigned* st) {
    XcdBarrier b; b.bar = bar; b.x = xb_xcc_id(); b.st = st;
    if (threadIdx.x == 0) (void)xb_add(&bar[XB_XCNT(b.x)], 1u);
    return b;
}
__device__ __forceinline__ void xcd_barrier_complete(unsigned* bar, unsigned x, unsigned& nloc, unsigned& nx) {
    const unsigned G = gridDim.x * gridDim.y * gridDim.z;
    unsigned sum, cnt, mine, sp = 0u;
    for (;;) {
        sum = 0u; cnt = 0u; mine = 0u;
#pragma unroll
        for (unsigned j = 0; j < 16; ++j) { const unsigned c = xb_ld(&bar[XB_XCNT(j)]); sum += c; cnt += (c > 0u) ? 1u : 0u; mine = (j == x) ? c : mine; }
        if (sum == G) break;
        __builtin_amdgcn_s_sleep(1);
        if ((++sp & 255u) == 0u) { if (xb_ld(&bar[XB_TMO])) break; if (sp > XB_SPIN_CAP) { atomicAdd(&bar[XB_TMO], 1u); break; } }
    }
    nloc = mine > 0u ? mine : 1u; nx = cnt > 0u ? cnt : 1u;
}

__device__ __forceinline__ void xcd_barrier(const XcdBarrier& b) {
    asm volatile("s_waitcnt vmcnt(0)" ::: "memory");
    __syncthreads();
    if (threadIdx.x == 0) {
        unsigned* bar = b.bar;
        __builtin_amdgcn_s_waitcnt(0);
        unsigned nloc = b.st[0], nx = b.st[1];
        if (nloc == 0u) { xcd_barrier_complete(bar, b.x, nloc, nx); b.st[0] = nloc; b.st[1] = nx; }
        const unsigned old = xb_add(&bar[XB_XSUB(b.x)], 1u);
        const unsigned gen = old / nloc;
        if (old + 1u == (gen + 1u) * nloc) {
            __builtin_amdgcn_fence(__ATOMIC_RELEASE, "agent");
            asm volatile("s_waitcnt vmcnt(0)" ::: "memory");
            const unsigned og = xb_add(&bar[XB_TOP], 1u);
            const unsigned tg = og / nx;
            if (og + 1u == (tg + 1u) * nx) xb_add(&bar[XB_TOPGEN], 1u);
            else XB_SPIN(xb_ld(&bar[XB_TOPGEN]) == tg, bar);
            __builtin_amdgcn_fence(__ATOMIC_ACQUIRE, "agent");
            xb_add(&bar[XB_XGEN(b.x)], 1u);
            asm volatile("s_waitcnt vmcnt(0)" ::: "memory");
        } else {
            XB_SPIN(xb_ld(&bar[XB_XGEN(b.x)]) == gen, bar);
            __builtin_amdgcn_fence(__ATOMIC_ACQUIRE, "agent");
            asm volatile("s_waitcnt vmcnt(0)" ::: "memory");
        }
    }
    __syncthreads();
}

__device__ __forceinline__ ArgsP kargs() { ArgsP p = (ArgsP)__builtin_amdgcn_kernarg_segment_ptr(); asm volatile("" : "+s"(p)); return p; }
__global__ void __launch_bounds__(NWAVES * 64, 2) fwd_kernel(Args a_) {
    extern __shared__ __attribute__((aligned(16))) unsigned char lds_raw[];
    const int ph_lo = kargs()->ph_lo;
    const bool one_launch = kargs()->ph_hi - ph_lo > 1;
    if (one_launch) { volatile LAS unsigned* st0 = (volatile LAS unsigned*)((LAS unsigned char*)lds_raw + MISC_OFF);
        if (threadIdx.x < 4) st0[threadIdx.x] = 0u;
        __syncthreads();
        (void)xcd_barrier_post((unsigned*)(kargs()->ws + WS_CTL), st0); }
    for (int st = ph_lo; ; ++st) {
        if (st == 0) {
            ArgsP ap = kargs(); LAS unsigned char* lds = (LAS unsigned char*)lds_raw;
            const int tid = ltid(), lane = tid & 63, wave = __builtin_amdgcn_readfirstlane(tid >> 6);
            const int G = lgrid(), bx = lbid(), vcu = (G % 8 == 0) ? (bx % 8) * (G / 8) + bx / 8 : bx;
            prologue(ap, lds, wave, lane, vcu, G);
        } else {
            const int l = (st - 1) / 7, ph = (st - 1) % 7; const bool attn = (l & 1) == 0;
            if (ph == 0 || ph == 5) {
                ArgsP ap = kargs(); LAS unsigned char* lds = (LAS unsigned char*)lds_raw; unsigned char* ws = ap->ws; const int G = lgrid(), bx = lbid();
                LAS float* rs = (LAS float*)(lds + RS_OFF);
                unsigned char* wffn = ws + WS_WFFN + (size_t)(l * 2 + (ph >= 5 ? 1 : 0)) * FFN_STRIDE;
                pg8::Gemm g{(const bf16*)(ws + WS_XB), (const bf16*)wffn, M, 2 * DFF, D, XBP, 0, 0}; pg8::StaticOrder S; S.init(M, 2 * DFF, G, bx);
                fill_rs(rs, (const float*)(ws + WS_PART), S, ltid());
                pg8::EpiSwiglu E{(bf16*)(ws + WS_ACT), rs, DFF};
                pg8::gemm_phase<pg8::EpiSwiglu, pg8::StaticOrder, true, true>(lds, g, S, E);
            } else if (ph == 1 || ph == 4 || ph == 6) {
                ArgsP ap = kargs(); LAS unsigned char* lds = (LAS unsigned char*)lds_raw; unsigned char* ws = ap->ws; const int G = lgrid(), bx = lbid(); const int j = l >> 1;
                unsigned char* wffn = ws + WS_WFFN + (size_t)(l * 2 + (ph >= 5 ? 1 : 0)) * FFN_STRIDE; unsigned char* wmix = ws + WS_WMIX + MIX_OFF(l);
                pg8::Gemm g; const float* bias = nullptr; float alpha = 1.f;
                if (ph != 4) { g = pg8::Gemm{(const bf16*)(ws + WS_ACT), (const bf16*)(wffn + FFN_DOWN_OFF), M, D, DFF, DFF, 0, 0}; alpha = 0.5f; }
                else if (attn) { g = pg8::Gemm{(const bf16*)(ws + WS_O), (const bf16*)(wmix + 6 * MiB), M, D, D, D, 0, 0}; }
                else { g = pg8::Gemm{(const bf16*)(ws + WS_ACT), (const bf16*)(wmix + 8 * MiB), M, D, GH, 256, (size_t)8 * 32768 * 2, (size_t)32768 * 2};     bias = ap->in[24] + (size_t)j * D; }
                pg8::StaticOrder S; S.init(M, D, G, bx);
                pg8::EpiResid E{ap->in[0], ap->out, (bf16*)(ws + WS_XB), (float*)(ws + WS_PART), bias, alpha, (st == 2) ? 1 : ((st == NPHASE - 1) ? 2 : 0)};
                pg8::gemm_phase<pg8::EpiResid, pg8::StaticOrder, true, true>(lds, g, S, E);
            } else if (ph == 2) {
                ArgsP ap = kargs(); LAS unsigned char* lds = (LAS unsigned char*)lds_raw; unsigned char* ws = ap->ws; const int G = lgrid(), bx = lbid(); const int j = l >> 1;
                LAS float* rs = (LAS float*)(lds + RS_OFF); unsigned char* wmix = ws + WS_WMIX + MIX_OFF(l);
                if (attn) {
                    pg8::Gemm g{(const bf16*)(ws + WS_XB), (const bf16*)wmix, M, 3072, D, XBP, 0, 0}; pg8::StaticOrder S; S.init(M, 3072, G, bx);
                    fill_rs(rs, (const float*)(ws + WS_PART), S, ltid(), rs + 2048, nullptr, ap->in[10] + j * 64, ap->in[11] + j * 64, attn_body::C2);
                    pg8::EpiQKV E{(bf16*)(ws + WS_ACT), rs, rs + 2048};
                    pg8::gemm_phase<pg8::EpiQKV, pg8::StaticOrder, true, true>(lds, g, S, E);
                } else {
                    pg8::Gemm g{(const bf16*)(ws + WS_XB), (const bf16*)wmix, M, 4096, D, XBP, 0, 0}; pg8::StaticOrder S; S.init(M, 4096, G, bx);
                    fill_rs(rs, (const float*)(ws + WS_PART), S, ltid(), rs + 2048, ap->in[18] + (size_t)j * 4096);
                    pg8::EpiGmlpIn E{(bf16*)(ws + WS_ACT), rs, rs + 2048, (float*)(ws + WS_STATS)};
                    pg8::gemm_phase<pg8::EpiGmlpIn, pg8::StaticOrder, true, true>(lds, g, S, E);
                }
            } else {
                if (attn) { attn_body::dattn_phase2<0>(l, (char*)lds_raw, WS_ACT, WS_O); }
                else { ArgsP ap = kargs(); LAS unsigned char* lds = (LAS unsigned char*)lds_raw; unsigned char* ws = ap->ws; const int j = l >> 1;
                    sgu_phase(lds, (bf16*)(ws + WS_ACT), (const float*)(ws + WS_STATS), (const bf16*)(ws + WS_WSB) + (size_t)j * 8 * 16384, ap->in[19] + (size_t)j * GH, ap->in[20] + (size_t)j * GH, ap->in[22] + (size_t)j * 1024, lgrid(), lbid()); }
            }
        }
        if (st + 1 >= kargs()->ph_hi) break;
        if (st == 0) cg::this_grid().sync();
        else { XcdBarrier xb_; xb_.bar = (unsigned*)(kargs()->ws + WS_CTL); xb_.x = xb_xcc_id(); xb_.st = (volatile LAS unsigned*)((LAS unsigned char*)lds_raw + MISC_OFF); xcd_barrier(xb_); }
    }
}

#ifndef MK_MULTI
#define MK_MULTI 0
#endif
extern "C" void kernel_launch(void* const* d_in, const int* in_sizes, int n_in, void* d_out, int out_size, void* d_ws, size_t ws_size, hipStream_t stream) {
    static int grid = 0;
    if (grid == 0) {
        if (n_in != 25 || in_sizes[0] != M * D || out_size != M * D || ws_size < WS_END) { fprintf(stderr, "kernel_launch: unexpected shapes: n_in %d in0 %d out %d ws %zu\n", n_in, n_in > 0 ? in_sizes[0] : -1, out_size, ws_size); grid = -1; return; }
        int dev = 0, cus = 0, per_cu = 0;
        (void)hipGetDevice(&dev); (void)hipDeviceGetAttribute(&cus, hipDeviceAttributeMultiprocessorCount, dev);
        if (hipFuncSetAttribute((const void*)fwd_kernel, hipFuncAttributeMaxDynamicSharedMemorySize, LDS_BYTES) != hipSuccess) { fprintf(stderr, "kernel_launch: hipFuncSetAttribute failed\n"); grid = -1; return; }
        if (hipOccupancyMaxActiveBlocksPerMultiprocessor(&per_cu, (const void*)fwd_kernel, NWAVES * 64, LDS_BYTES) != hipSuccess || per_cu < 1) { fprintf(stderr, "kernel_launch: occupancy query says %d\n", per_cu); per_cu = 1; }
        (void)hipGetLastError();
        grid = cus * 1;
        fprintf(stderr, "kernel_launch: grid %d (cus %d, per_cu %d)\n", grid, cus, per_cu);
    }
    if (grid < 0) return;
    (void)hipMemsetAsync((char*)d_ws + WS_CTL, 0, CTL_ZERO_BYTES, stream);
    Args a{};
    for (int i = 0; i < 25; ++i) a.in[i] = (const float*)d_in[i];
    a.out = (float*)d_out; a.ws = (unsigned char*)d_ws;
#if MK_MULTI
    for (int p = 0; p < NPHASE; ++p) { a.ph_lo = p; a.ph_hi = p + 1; hipLaunchKernelGGL(fwd_kernel, dim3(grid), dim3(NWAVES * 64), LDS_BYTES, stream, a); }
#else
    a.ph_lo = 0; a.ph_hi = NPHASE;
    void* kargs[] = {&a};
    hipError_t e = hipLaunchCooperativeKernel((const void*)fwd_kernel, dim3(grid), dim3(NWAVES * 64), kargs, LDS_BYTES, stream);
    if (e != hipSuccess) fprintf(stderr, "kernel_launch: cooperative launch failed: %s (grid %d)\n", hipGetErrorString(e), grid);
#endif
}
```

```cpp
#include <hip/hip_runtime.h>
#include <hip/hip_cooperative_groups.h>
#include <cstdio>
#include <cstdint>
namespace cg = cooperative_groups;
__device__ __forceinline__ int ltid() { int t = threadIdx.x; asm volatile("" : "+v"(t)); return t; }
__device__ __forceinline__ int lbid() { int t = blockIdx.x; asm volatile("" : "+s"(t)); return t; }
__device__ __forceinline__ int lgrid() { int t = gridDim.x; asm volatile("" : "+s"(t)); return t; }
namespace pg8 {
#define PG8_LAS __attribute__((address_space(3)))
typedef unsigned short bf16_t;
typedef short bf16x8 __attribute__((ext_vector_type(8)));
typedef float f32x4 __attribute__((ext_vector_type(4)));
typedef unsigned u32x4 __attribute__((ext_vector_type(4)));
constexpr int BM = 256, BK = 64, HALF = 128, HTB = HALF * BK * 2  , STAGE_BYTES = 8 * HTB, NXCD = 8, WGM = 8;

__host__ __device__ __forceinline__ int lds_byte(int r, int c) { const int st = (r >> 4) * 2 + (c >> 5), rr = r & 15, cc = c & 31, ob = rr * 64 + cc * 2; return st * 1024 + (ob ^ (((ob >> 9) & 1) << 5)); }
__host__ __device__ __forceinline__ void stage_rc(int b, int& R, int& C) { const int st = b / 1024, sb = b % 1024, swz = sb ^ (((sb >> 9) & 1) << 5); R = (st >> 1) * 16 + swz / 64; C = (st & 1) * 32 + (swz % 64) / 2; }
__host__ __device__ __forceinline__ int perm32(int rho) { const int n = rho >> 4, i = rho & 15; return 8 * (i >> 2) + 4 * n + (i & 3); }

struct Unit { int pm, pn, ui; };
struct Gemm { const bf16_t* A; const bf16_t* Bt; int M, N, K, lda; size_t hstepA, gstrA; };

struct StaticOrder {
    int nM, nN, nwg, G, c;
    __host__ __device__ void init(int M, int N, int G_, int c_) { nM = M / BM; nN = N / BM; nwg = nM * nN; G = G_; c = c_; }
    __host__ __device__ bool next(int i, Unit& u) const {
        const long L = (long)i * G + c; if (L >= nwg) return false;
        int wgid = (int)L; { const int q = nwg / NXCD, r = nwg % NXCD, xcd = wgid % NXCD, off = wgid / NXCD; wgid = (xcd < r ? xcd * (q + 1) : r * (q + 1) + (xcd - r) * q) + off; }
        const int nig = WGM * nN, gid = wgid / nig, fm = gid * WGM, gsz = (nM - fm) < WGM ? (nM - fm) : WGM;
        u.pm = fm + ((wgid % nig) % gsz); u.pn = (wgid % nig) / gsz; u.ui = i; return true;
    }
    __device__ __forceinline__ void a_ready(const Unit&) const {}
    __device__ __forceinline__ void done(const Unit&) const {}
};
struct PairOrder {
    int nN2, p, m;
    __host__ __device__ void init(int M, int N, int G_, int c_) { nN2 = (N / BM) / 2; const int v = (G_ % 8 == 0) ? (c_ % 8) * (G_ / 8) + c_ / 8 : c_; p = v >> 1; m = v & 1; (void)M; }
    __device__ __forceinline__ bool next(int i, Unit& u) const { if (i >= nN2) return false; int pp = p; asm volatile("" : "+s"(pp));
        u.pm = pp; u.pn = m * nN2 + i; u.ui = i; return true; }
    __device__ __forceinline__ void a_ready(const Unit&) const {}
    __device__ __forceinline__ void done(const Unit&) const {}
};


__device__ __forceinline__ unsigned cvt_pk_bf16(float lo, float hi) { unsigned r; asm volatile("v_cvt_pk_bf16_f32 %0, %1, %2" : "=v"(r) : "v"(lo), "v"(hi)); return r; }
typedef float f32x2 __attribute__((ext_vector_type(2)));
__device__ __forceinline__ f32x2 gelu_pk(f32x2 v) {
    const f32x2 av = __builtin_elementwise_abs(v), d = av * 0.2316418882f + 1.0f;
    f32x2 t; t.x = __builtin_amdgcn_rcpf(d.x); t.y = __builtin_amdgcn_rcpf(d.y);
    f32x2 q = t * 0.5307027145f + (-0.7265760135f); q = q * t + 0.7107068705f; q = q * t + (-0.142248368f); q = q * t + 0.127414796f; q = q * t;
    const f32x2 s = (v * v) * (-0.72134752044f);
    f32x2 e; e.x = __builtin_amdgcn_exp2f(s.x); e.y = __builtin_amdgcn_exp2f(s.y);
    const f32x2 mx = (f32x2){__builtin_fmaxf(v.x, 0.f), __builtin_fmaxf(v.y, 0.f)};
    return mx - av * (q * e);
}
__device__ __forceinline__ float silu_f(float x) { return x * __builtin_amdgcn_rcpf(1.0f + __builtin_amdgcn_exp2f(-1.4426950408889634f * x)); }
__device__ __forceinline__ float dot4(f32x4 v) { return (v[0] * v[0] + v[1] * v[1]) + (v[2] * v[2] + v[3] * v[3]); }
__device__ __forceinline__ float sum4(f32x4 v) { return (v[0] + v[1]) + (v[2] + v[3]); }
__device__ __forceinline__ u32x4 pack8(f32x4 a, f32x4 b) { u32x4 w; w.x = cvt_pk_bf16(a[0], a[1]); w.y = cvt_pk_bf16(a[2], a[3]); w.z = cvt_pk_bf16(b[0], b[1]); w.w = cvt_pk_bf16(b[2], b[3]); return w; }

#ifndef EPI_WT
#define EPI_WT 0
#endif
__device__ __forceinline__ void st16(void* p, u32x4 v) {
#if EPI_WT
    asm volatile("global_store_dwordx4 %0, %1, off sc1\n\ts_nop 1" :: "v"(p), "v"(v) : "memory");
#else
    *(u32x4*)p = v;
#endif
}
__device__ __forceinline__ float rowsum4(float v) {
    auto a = __builtin_amdgcn_permlane16_swap(__float_as_uint(v), __float_as_uint(v), false, false); const float s = __uint_as_float(a[0]) + __uint_as_float(a[1]);
    auto b = __builtin_amdgcn_permlane32_swap(__float_as_uint(s), __float_as_uint(s), false, false); return __uint_as_float(b[0]) + __uint_as_float(b[1]);
}
struct EpiSwiglu {
    static constexpr bool PERM = true, AFTER_DRAIN = false, HAS_PREFETCH = false;
    bf16_t* O; const PG8_LAS float* rs; int ldo;
    __device__ __forceinline__ void operator()(const f32x4 (&acc)[2][2][4][2], const Unit& u, int wr, int wc, int fr, int fq) const {
        const int rl0 = wr * 64 + fr, col0 = u.pn * HALF + wc * 32 + 8 * fq;
#pragma unroll
        for (int ai = 0; ai < 2; ++ai)
#pragma unroll
            for (int m = 0; m < 4; ++m) { const int rl = rl0 + ai * HALF + m * 16; const float s = rs[u.ui * BM + rl];
                f32x4 h[2]; const float ns = -1.4426950408889634f * s, s2 = s * s;
#pragma unroll
                for (int n = 0; n < 2; ++n) { const f32x4 g = acc[ai][0][m][n], up = acc[ai][1][m][n]; const f32x4 ea = g * ns;
                    const f32x4 d = (f32x4){__builtin_amdgcn_exp2f(ea[0]), __builtin_amdgcn_exp2f(ea[1]), __builtin_amdgcn_exp2f(ea[2]), __builtin_amdgcn_exp2f(ea[3])} + 1.0f;
                    const f32x4 r = (f32x4){__builtin_amdgcn_rcpf(d[0]), __builtin_amdgcn_rcpf(d[1]), __builtin_amdgcn_rcpf(d[2]), __builtin_amdgcn_rcpf(d[3])};
                    h[n] = (g * up) * (r * s2); }
                st16(O + (size_t)(u.pm * BM + rl) * ldo + col0, pack8(h[0], h[1])); }
    }
};
#ifndef RESID_USE_LO
#define RESID_USE_LO 0
#endif
struct EpiResid {
    static constexpr bool PERM = true, AFTER_DRAIN = false, HAS_PREFETCH = false, LO = (RESID_USE_LO != 0);
    static constexpr int XBP_E = 1024;
    const float* xin; float* out; bf16_t* xb; float* part; const float* bias; float alpha; int mode;
    template <bool RD32, bool WR32> __device__ __forceinline__ void body(const f32x4 (&acc)[2][2][4][2], const Unit& u, int wr, int wc, int fr, int fq) const {
        const int rl0 = wr * 64 + fr, col0 = u.pn * BM + wc * 32 + 8 * fq;
        const size_t off0 = (size_t)(u.pm * BM + rl0) * 1024 + col0;
        const size_t off0x = (size_t)(u.pm * BM + rl0) * XBP_E + col0;
        constexpr int DEPTH = (RD32 || LO) ? 2 : 8;
        f32x4 pre[DEPTH][2][2];
#define RES_LOAD(slot, gi) do { const size_t o_ = off0 + (size_t)(((gi) >> 2) * HALF + ((gi) & 3) * 16) * 1024, ox_ = off0x + (size_t)(((gi) >> 2) * HALF + ((gi) & 3) * 16) * XBP_E; \
            if (RD32) { const float* p_ = xin + o_; pre[slot][0][0] = *(const f32x4*)(p_); pre[slot][0][1] = *(const f32x4*)(p_ + 4); pre[slot][1][0] = *(const f32x4*)(p_ + HALF); pre[slot][1][1] = *(const f32x4*)(p_ + HALF + 4); } \
            else { const bf16_t* h_ = xb + ox_; const float* l_ = out + o_; pre[slot][0][0] = *(const f32x4*)(h_); pre[slot][1][0] = *(const f32x4*)(h_ + HALF); if (LO) { pre[slot][0][1] = *(const f32x4*)(l_); pre[slot][1][1] = *(const f32x4*)(l_ + 4); } } } while (0)
#pragma unroll
        for (int gi = 0; gi < DEPTH; ++gi) RES_LOAD(gi, gi);
        f32x4 bv[2][2];
#pragma unroll
        for (int bj = 0; bj < 2; ++bj)
#pragma unroll
            for (int n = 0; n < 2; ++n) bv[bj][n] = bias ? *(const f32x4*)(bias + col0 + bj * HALF + 4 * n) * alpha : (f32x4){0.f, 0.f, 0.f, 0.f};
        asm volatile("" ::: "memory");
#pragma unroll
        for (int gi = 0; gi < 8; ++gi) { const int ai = gi >> 2, m = gi & 3; const int row = u.pm * BM + rl0 + ai * HALF + m * 16; const size_t off = (size_t)row * 1024 + col0, offx = (size_t)row * XBP_E + col0; float ss = 0.f;
            u32x4 lo_out[2];
#pragma unroll
            for (int bj = 0; bj < 2; ++bj) {
                f32x4 x0, x1;
                if (RD32) { x0 = pre[gi % DEPTH][bj][0]; x1 = pre[gi % DEPTH][bj][1]; }
                else { const u32x4 h = __builtin_bit_cast(u32x4, pre[gi % DEPTH][bj][0]);
                    x0 = (f32x4){__uint_as_float(h.x << 16), __uint_as_float(h.x & 0xffff0000u), __uint_as_float(h.y << 16), __uint_as_float(h.y & 0xffff0000u)};
                    x1 = (f32x4){__uint_as_float(h.z << 16), __uint_as_float(h.z & 0xffff0000u), __uint_as_float(h.w << 16), __uint_as_float(h.w & 0xffff0000u)};
                    if (LO) { const u32x4 l = __builtin_bit_cast(u32x4, pre[gi % DEPTH][bj][1]);
                        x0 = x0 + (f32x4){__uint_as_float(l.x << 16), __uint_as_float(l.x & 0xffff0000u), __uint_as_float(l.y << 16), __uint_as_float(l.y & 0xffff0000u)};
                        x1 = x1 + (f32x4){__uint_as_float(l.z << 16), __uint_as_float(l.z & 0xffff0000u), __uint_as_float(l.w << 16), __uint_as_float(l.w & 0xffff0000u)}; } }
                if (bias) { x0 = x0 + bv[bj][0]; x1 = x1 + bv[bj][1]; }
                const f32x4 v0 = x0 + acc[ai][bj][m][0] * alpha, v1 = x1 + acc[ai][bj][m][1] * alpha;
                ss += dot4(v0) + dot4(v1);
                if (WR32) { *(f32x4*)(out + off + bj * HALF) = v0; *(f32x4*)(out + off + bj * HALF + 4) = v1; }
                else { const u32x4 hn = pack8(v0, v1); st16(xb + offx + bj * HALF, hn);
                    const f32x4 r0 = v0 - (f32x4){__uint_as_float(hn.x << 16), __uint_as_float(hn.x & 0xffff0000u), __uint_as_float(hn.y << 16), __uint_as_float(hn.y & 0xffff0000u)};
                    const f32x4 r1 = v1 - (f32x4){__uint_as_float(hn.z << 16), __uint_as_float(hn.z & 0xffff0000u), __uint_as_float(hn.w << 16), __uint_as_float(hn.w & 0xffff0000u)};
                    lo_out[bj] = pack8(r0, r1); } }
            if (!WR32 && LO) { *(u32x4*)(out + off) = lo_out[0]; *(u32x4*)(out + off + 4) = lo_out[1]; }
            ss = rowsum4(ss);
            if (!WR32) { if (fq == 0) part[(size_t)row * 16 + u.pn * 4 + wc] = ss; }
            asm volatile("" ::: "memory");
            if (gi + DEPTH < 8) { RES_LOAD(gi % DEPTH, gi + DEPTH); asm volatile("" ::: "memory"); } }
#undef RES_LOAD
    }
    __device__ __forceinline__ void operator()(const f32x4 (&acc)[2][2][4][2], const Unit& u, int wr, int wc, int fr, int fq) const {
        if (mode == 1) body<true, false>(acc, u, wr, wc, fr, fq);
        else if (mode == 2) body<false, true>(acc, u, wr, wc, fr, fq);
        else body<false, false>(acc, u, wr, wc, fr, fq);
    }
};
struct EpiQKV {
    static constexpr bool PERM = true, AFTER_DRAIN = false, HAS_PREFETCH = false;
    bf16_t* O; const PG8_LAS float* rs; const PG8_LAS float* aux;
    __device__ __forceinline__ void operator()(const f32x4 (&acc)[2][2][4][2], const Unit& u, int wr, int wc, int fr, int fq) const {
        const int rl0 = wr * 64 + fr, kind = u.pn >> 2, colb = u.pn * BM + wc * 64 + 8 * fq;
        f32x4 gv[2][2]; const PG8_LAS float* gp = aux + (kind == 0 ? 0 : 64);
#pragma unroll
        for (int bj = 0; bj < 2; ++bj)
#pragma unroll
            for (int n = 0; n < 2; ++n) gv[bj][n] = *(const PG8_LAS f32x4*)(gp + 32 * bj + 8 * fq + 4 * n);
#pragma unroll
        for (int ai = 0; ai < 2; ++ai)
#pragma unroll
            for (int m = 0; m < 4; ++m) { const int rl = rl0 + ai * HALF + m * 16; const float s = rs[u.ui * BM + rl];
                f32x4 v[2][2]; float ss = 0.f;
#pragma unroll
                for (int bj = 0; bj < 2; ++bj)
#pragma unroll
                    for (int n = 0; n < 2; ++n) { v[bj][n] = acc[ai][bj][m][n] * s; ss += dot4(v[bj][n]); }
                if (kind < 2) { ss = rowsum4(ss); const float sc = rsqrtf(ss * (1.0f / 64.0f) + 1e-6f);
#pragma unroll
                    for (int bj = 0; bj < 2; ++bj)
#pragma unroll
                        for (int n = 0; n < 2; ++n) v[bj][n] = v[bj][n] * sc * gv[bj][n]; }
                bf16_t* p = O + (size_t)(u.pm * BM + rl) * 3072 + colb;
                *(u32x4*)(p) = pack8(v[0][0], v[0][1]); *(u32x4*)(p + 32) = pack8(v[1][0], v[1][1]); }
    }
};
struct EpiGmlpIn {
    static constexpr bool PERM = true, AFTER_DRAIN = false, HAS_PREFETCH = false;
    bf16_t* Z; const PG8_LAS float* rs; const PG8_LAS float* aux; float* stats;
    __device__ __forceinline__ void operator()(const f32x4 (&acc)[2][2][4][2], const Unit& u, int wr, int wc, int fr, int fq) const {
        const int rl0 = wr * 64 + fr, col0 = u.pn * BM + wc * 32 + 8 * fq; const bool isv = u.pn >= 8;
        f32x4 bv[2][2];
#pragma unroll
        for (int bj = 0; bj < 2; ++bj)
#pragma unroll
            for (int n = 0; n < 2; ++n) bv[bj][n] = *(const PG8_LAS f32x4*)(aux + u.ui * BM + wc * 32 + 8 * fq + bj * HALF + 4 * n);
#pragma unroll
        for (int ai = 0; ai < 2; ++ai)
#pragma unroll
            for (int m = 0; m < 4; ++m) { const int rl = rl0 + ai * HALF + m * 16; const float s = rs[u.ui * BM + rl]; const size_t row = (size_t)(u.pm * BM + rl);
                float sm = 0.f, sq = 0.f;
#pragma unroll
                for (int bj = 0; bj < 2; ++bj) { f32x4 v0 = acc[ai][bj][m][0] * s + bv[bj][0], v1 = acc[ai][bj][m][1] * s + bv[bj][1];
                    const f32x2 a = gelu_pk((f32x2){v0[0], v0[1]}), b = gelu_pk((f32x2){v0[2], v0[3]}), c = gelu_pk((f32x2){v1[0], v1[1]}), d = gelu_pk((f32x2){v1[2], v1[3]});
                    v0 = (f32x4){a.x, a.y, b.x, b.y}; v1 = (f32x4){c.x, c.y, d.x, d.y};
                    *(u32x4*)(Z + (isv ? (size_t)256 * 8 * 32768 : (size_t)0) + ((size_t)((2 * u.pm + ai) * 8 + (u.pn & 7)) * 128 + (rl & 127)) * 256 + wc * 32 + 8 * fq + bj * HALF) = pack8(v0, v1);
                    sm += sum4(v0) + sum4(v1); sq += dot4(v0) + dot4(v1); }
                if (isv) { sm = rowsum4(sm); sq = rowsum4(sq);
                    if (fq == 0) *(f32x2*)(stats + (row * 32 + (u.pn - 8) * 4 + wc) * 2) = (f32x2){sm, sq}; } }
    }
};
template <class Epi, class Sched, bool ALIGN_EPI = false, bool SP2 = false>
__device__ __forceinline__ void gemm_phase(PG8_LAS unsigned char* lds, const Gemm g, const Sched& S, const Epi& E) {
    const int tid = ltid(), wid = __builtin_amdgcn_readfirstlane(tid >> 6), lane = tid & 63, wr = wid >> 2, wc = wid & 3, fr = lane & 15, fq = lane >> 4;
    const int K = g.K, nt = K / BK;
    unsigned voffA[2], voffB[2];
#pragma unroll
    for (int i = 0; i < 2; ++i) { int R, C; stage_rc(tid * 16 + i * 8192, R, C); const int Rb = Epi::PERM ? ((R & ~31) + perm32(R & 31)) : R;
        voffA[i] = (unsigned)(R * g.lda + C) * 2u; voffB[i] = (unsigned)(Rb * K + C) * 2u; }
    const size_t kstep = (size_t)(BK * 2);
    const size_t hstep = (size_t)HALF * K * 2;
    const size_t tstep = 2 * hstep; const size_t hstepA = g.hstepA ? g.hstepA : (size_t)HALF * g.lda * 2, tstepA = 2 * hstepA;
    const unsigned ldsw = (unsigned)wid * 1024u;
    const int aoff = lds_byte(wr * 64 + fr, fq * 8), boff = lds_byte(wc * 32 + fr, fq * 8);
#define PG8_SA(b, h) (((b) * 2 + (h)) * HTB)
#define PG8_SB(b, h) ((4 + (b) * 2 + (h)) * HTB)
#define PG8_STAGE(bufoff, gbase, voff) do { _Pragma("unroll") for (int _i = 0; _i < 2; ++_i) \
        __builtin_amdgcn_global_load_lds((const unsigned*)((const char*)(gbase) + (voff)[_i]), (PG8_LAS unsigned*)(lds + (bufoff) + ldsw + _i * 8192), 16, 0, 0); } while (0)
#define PG8_LDA(dst, b, h) do { _Pragma("unroll") for (int m = 0; m < 4; ++m) _Pragma("unroll") for (int k = 0; k < 2; ++k) dst[m][k] = *(const PG8_LAS bf16x8*)(lds + PG8_SA(b, h) + aoff + m * 2048 + k * 1024); } while (0)
#define PG8_LDB(dst, b, h) do { _Pragma("unroll") for (int n = 0; n < 2; ++n) _Pragma("unroll") for (int k = 0; k < 2; ++k) dst[n][k] = *(const PG8_LAS bf16x8*)(lds + PG8_SB(b, h) + boff + n * 2048 + k * 1024); } while (0)
#define PG8_MMA(ai, bj, At, Bt) do { __builtin_amdgcn_s_setprio(1); _Pragma("unroll") for (int m = 0; m < 4; ++m) _Pragma("unroll") for (int n = 0; n < 2; ++n) _Pragma("unroll") for (int k = 0; k < 2; ++k) \
        acc[ai][bj][m][n] = __builtin_amdgcn_mfma_f32_16x16x32_bf16(Bt[n][k], At[m][k], acc[ai][bj][m][n], 0, 0, 0); __builtin_amdgcn_s_setprio(0); } while (0)
#define PG8_WAIT_V(n) asm volatile("s_waitcnt vmcnt(" #n ")" ::: "memory")
#define PG8_WAIT_L(n) asm volatile("s_waitcnt lgkmcnt(" #n ")" ::: "memory")
#define PG8_BAR __builtin_amdgcn_s_barrier()
#define PG8_SCHED __builtin_amdgcn_sched_barrier(0)
    Unit cur, nxt; int ui = 0;
    if (!S.next(0, cur)) return;
    f32x4 acc[2][2][4][2];
#pragma unroll
    for (int a = 0; a < 2; ++a)
#pragma unroll
        for (int b = 0; b < 2; ++b)
#pragma unroll
            for (int m = 0; m < 4; ++m)
#pragma unroll
                for (int n = 0; n < 2; ++n) acc[a][b][m][n] = (f32x4){0.f, 0.f, 0.f, 0.f};
    bf16x8 At[4][2], B0[2][2], B1[2][2];
    const char* cA = (const char*)g.A + (size_t)cur.pm * tstepA; const char* cB = (const char*)g.Bt + (size_t)cur.pn * tstep;
    S.a_ready(cur);
    if constexpr (SP2) {
        PG8_STAGE(PG8_SB(0, 0), cB, voffB); PG8_STAGE(PG8_SB(0, 1), cB + hstep, voffB); PG8_STAGE(PG8_SA(0, 0), cA, voffA); PG8_STAGE(PG8_SA(0, 1), cA + hstepA, voffA);
        if (wr == 1) PG8_BAR;
        PG8_WAIT_V(2); PG8_BAR;
        PG8_STAGE(PG8_SB(1, 0), cB + kstep, voffB); PG8_STAGE(PG8_SA(1, 0), cA + kstep, voffA); PG8_STAGE(PG8_SB(1, 1), cB + hstep + kstep, voffB);
        PG8_WAIT_V(6); PG8_BAR;
    } else {
        PG8_STAGE(PG8_SB(0, 0), cB, voffB); PG8_STAGE(PG8_SA(0, 0), cA, voffA); PG8_STAGE(PG8_SB(0, 1), cB + hstep, voffB); PG8_STAGE(PG8_SA(0, 1), cA + hstepA, voffA);
        if (wr == 1) PG8_BAR;
        PG8_WAIT_V(4); PG8_BAR;
        PG8_STAGE(PG8_SB(1, 0), cB + kstep, voffB); PG8_STAGE(PG8_SA(1, 0), cA + kstep, voffA); PG8_STAGE(PG8_SB(1, 1), cB + hstep + kstep, voffB);
        PG8_WAIT_V(6); PG8_BAR;
    }
    for (;;) {
        const bool has_next = S.next(ui + 1, nxt);
        const char* nA = has_next ? (const char*)g.A + (size_t)nxt.pm * tstepA : cA; const char* nB = has_next ? (const char*)g.Bt + (size_t)nxt.pn * tstep : cB;
        for (int t = 0; t < nt; t += 2) {
            const bool last = (t == nt - 2);
            const char* a1 = cA + (g.gstrA ? (size_t)(t >> 2) * g.gstrA + (size_t)(t & 3) * kstep : (size_t)t * kstep) + kstep;
            const char* a2 = last ? nA : cA + (g.gstrA ? (size_t)((t + 2) >> 2) * g.gstrA + (size_t)((t + 2) & 3) * kstep : (size_t)(t + 2) * kstep); const char* b2 = last ? nB : cB + (size_t)(t + 2) * kstep;
            const char* a3 = a2 + kstep; const char* b3 = b2 + kstep;
            if (last && has_next) S.a_ready(nxt);
            if constexpr (Epi::HAS_PREFETCH) { if (t == nt - 4) E.prefetch(cur, tid, wid); }
            if constexpr (SP2) {
            PG8_LDB(B0, 0, 0); PG8_LDB(B1, 0, 1); PG8_SCHED; PG8_LDA(At, 0, 0); PG8_STAGE(PG8_SA(1, 1), a1 + hstepA, voffA);
            PG8_WAIT_V(8); PG8_WAIT_L(0); PG8_BAR; PG8_MMA(0, 0, At, B0); PG8_MMA(0, 1, At, B1); PG8_BAR; PG8_SCHED;
            PG8_LDA(At, 0, 1); PG8_STAGE(PG8_SB(0, 0), b2, voffB); PG8_STAGE(PG8_SB(0, 1), b2 + hstep, voffB); PG8_STAGE(PG8_SA(0, 0), a2, voffA);
            PG8_WAIT_V(8); PG8_WAIT_L(0); PG8_BAR; PG8_MMA(1, 0, At, B0); PG8_MMA(1, 1, At, B1); PG8_BAR; PG8_SCHED;
            PG8_LDB(B0, 1, 0); PG8_LDB(B1, 1, 1); PG8_SCHED; PG8_LDA(At, 1, 0); PG8_STAGE(PG8_SA(0, 1), a2 + hstepA, voffA);
            PG8_WAIT_V(8); PG8_WAIT_L(0); PG8_BAR; PG8_MMA(0, 0, At, B0); PG8_MMA(0, 1, At, B1); PG8_BAR; PG8_SCHED;
            PG8_LDA(At, 1, 1); PG8_STAGE(PG8_SB(1, 0), b3, voffB); PG8_STAGE(PG8_SB(1, 1), b3 + hstep, voffB); PG8_STAGE(PG8_SA(1, 0), a3, voffA);
            PG8_WAIT_V(8); PG8_WAIT_L(0); PG8_BAR; PG8_MMA(1, 0, At, B0); PG8_MMA(1, 1, At, B1); PG8_BAR; PG8_SCHED;
            } else {
            PG8_LDB(B0, 0, 0); PG8_SCHED; PG8_LDA(At, 0, 0); PG8_STAGE(PG8_SA(1, 1), a1 + hstepA, voffA);
            PG8_WAIT_L(8); PG8_BAR; PG8_WAIT_L(0); PG8_MMA(0, 0, At, B0); PG8_BAR; PG8_SCHED;
            PG8_LDB(B1, 0, 1); PG8_STAGE(PG8_SB(0, 0), b2, voffB);
            PG8_BAR; PG8_WAIT_L(0); PG8_MMA(0, 1, At, B1); PG8_BAR;
            PG8_LDA(At, 0, 1); PG8_STAGE(PG8_SA(0, 0), a2, voffA);
            PG8_BAR; PG8_WAIT_L(0); PG8_MMA(1, 0, At, B0); PG8_BAR; PG8_SCHED;
            PG8_STAGE(PG8_SB(0, 1), b2 + hstep, voffB);
            PG8_WAIT_V(6); PG8_BAR; PG8_MMA(1, 1, At, B1); PG8_BAR;
            PG8_LDB(B0, 1, 0); PG8_SCHED; PG8_LDA(At, 1, 0); PG8_STAGE(PG8_SA(0, 1), a2 + hstepA, voffA);
            PG8_WAIT_L(8); PG8_BAR; PG8_WAIT_L(0); PG8_MMA(0, 0, At, B0); PG8_BAR; PG8_SCHED;
            PG8_LDB(B1, 1, 1); PG8_STAGE(PG8_SB(1, 0), b3, voffB);
            PG8_BAR; PG8_WAIT_L(0); PG8_MMA(0, 1, At, B1); PG8_BAR;
            PG8_LDA(At, 1, 1); PG8_STAGE(PG8_SA(1, 0), a3, voffA);
            PG8_BAR; PG8_WAIT_L(0); PG8_MMA(1, 0, At, B0); PG8_BAR; PG8_SCHED;
            PG8_STAGE(PG8_SB(1, 1), b3 + hstep, voffB);
            PG8_WAIT_V(6); PG8_BAR; PG8_MMA(1, 1, At, B1); PG8_BAR;
            }
        }
        if constexpr (ALIGN_EPI) { if (wr == 0) PG8_BAR; }
        if constexpr (!Epi::AFTER_DRAIN) { E(acc, cur, wr, wc, fr, fq); S.done(cur); }
        if (!has_next) break;
#pragma unroll
        for (int a = 0; a < 2; ++a)
#pragma unroll
            for (int b = 0; b < 2; ++b)
#pragma unroll
                for (int m = 0; m < 4; ++m)
#pragma unroll
                    for (int n = 0; n < 2; ++n) acc[a][b][m][n] = (f32x4){0.f, 0.f, 0.f, 0.f};
        cur = nxt; cA = nA; cB = nB; ++ui;
        if constexpr (ALIGN_EPI) { if (wr == 1) PG8_BAR; }
    }
    PG8_WAIT_V(0);
    if constexpr (!ALIGN_EPI) { if (wr == 0) PG8_BAR; }
    PG8_BAR;
    if constexpr (Epi::AFTER_DRAIN) { E.fused(acc, cur, wr, wc, fr, fq, lds, wid, lane); S.done(cur); }
#undef PG8_SA
#undef PG8_SB
#undef PG8_STAGE
#undef PG8_LDA
#undef PG8_LDB
#undef PG8_MMA
#undef PG8_WAIT_V
#undef PG8_WAIT_L
#undef PG8_BAR
#undef PG8_SCHED
}
}

#ifndef PG8_SP2
#define PG8_SP2 true
#endif
#include <hip/hip_bf16.h>
#include <cmath>
namespace attn_body {
using bf16=__hip_bfloat16;
using bf16x8=__attribute__((ext_vector_type(8)))short;
using s16x4=__attribute__((ext_vector_type(4)))short;
using f32x16=__attribute__((ext_vector_type(16)))float;
using u32x4=__attribute__((ext_vector_type(4)))unsigned;
constexpr int BATCH=4,NHEAD=8,SEQ=8192,D=64,DM=3072,OPITCH=1024;
constexpr int NW=8,QBLK=32,QB=QBLK*NW,KVBLK=64,NQB=SEQ/QB;
constexpr int ATTN_PITCH=DM, ATTN_UNIT_ROWS=QB;
__device__ __forceinline__ int crow(int r,int hi){return (r&3)+8*(r>>2)+4*hi;}
#define SBAR() __builtin_amdgcn_sched_barrier(0)
__device__ __forceinline__ void cmask(f32x16&p0,f32x16&p1,int jb,int qrel,int hi){
  const float NEG=-INFINITY; int kb=64*jb+4*hi;
  #pragma unroll
  for(int r=0;r<16;++r){int kv=kb+(r&3)+8*(r>>2); if(kv>qrel)p0[r]=NEG; if(kv+32>qrel)p1[r]=NEG;}
}

constexpr int NSLOT=3, SLOTB=8192;
constexpr int LDS_K=0, LDS_V=NSLOT*SLOTB, LDS_WS=2*NSLOT*SLOTB, LDS_TMP=LDS_WS+NW*64*4, LDS_STY=LDS_TMP+NW*8192, LDS_LAM=LDS_STY+NW*4096, LDS_BYTES=LDS_LAM+64;
constexpr float C2=0.125f*1.4426950408889634f;
__device__ __forceinline__ void glds16(const void*gsrc,unsigned lds_dst){unsigned keep;
  asm volatile("s_mov_b32 %0, m0\n\ts_mov_b32 m0, %2\n\ts_nop 0\n\tglobal_load_lds_dwordx4 %1, off\n\ts_mov_b32 m0, %0":"=&s"(keep):"v"(gsrc),"s"(lds_dst):"memory");}
__device__ __forceinline__ float max3f(float a,float b,float c){float r;asm("v_max3_f32 %0, %1, %2, %3":"=v"(r):"v"(a),"v"(b),"v"(c));return r;}
__device__ __forceinline__ float max2f(float a,float b){float r;asm("v_max_f32_e32 %0, %1, %2":"=v"(r):"v"(a),"v"(b));return r;}
__device__ __forceinline__ float fadd_s(float a,float b){float r;asm("v_add_f32_e32 %0, %1, %2":"=v"(r):"v"(a),"v"(b));return r;}
__device__ __forceinline__ float fsub_s(float a,float b){float r;asm("v_sub_f32_e32 %0, %1, %2":"=v"(r):"v"(a),"v"(b));return r;}
typedef float f32x2_t __attribute__((ext_vector_type(2))); typedef __bf16 bf16x2_t __attribute__((ext_vector_type(2)));
__device__ __forceinline__ unsigned cvtpk_s(float lo,float hi){f32x2_t v={lo,hi};bf16x2_t b=__builtin_convertvector(v,bf16x2_t);return __builtin_bit_cast(unsigned,b);}
#define WAIT_BAR(N) asm volatile("s_waitcnt vmcnt(" #N ") lgkmcnt(0)\n\ts_barrier":::"memory")

__device__ __forceinline__ void qkt(f32x16&p0,f32x16&p1,const char*Kslot,const bf16x8*qr,const f32x16&negm,int r32,int hi){
  const char*kb=Kslot+hi*1024+r32*16;
  #pragma unroll
  for(int d0=0;d0<4;++d0){
    const bf16x8 b0=*reinterpret_cast<const bf16x8*>(kb+d0*2048);
    const bf16x8 b1=*reinterpret_cast<const bf16x8*>(kb+d0*2048+512);
    if(d0==0){p0=__builtin_amdgcn_mfma_f32_32x32x16_bf16(b0,qr[0],negm,0,0,0);p1=__builtin_amdgcn_mfma_f32_32x32x16_bf16(b1,qr[0],negm,0,0,0);}
    else{p0=__builtin_amdgcn_mfma_f32_32x32x16_bf16(b0,qr[d0],p0,0,0,0);p1=__builtin_amdgcn_mfma_f32_32x32x16_bf16(b1,qr[d0],p1,0,0,0);}}
}
typedef __attribute__((address_space(3))) const char* lds_cptr;
typedef short v4i16_t __attribute__((ext_vector_type(4)));
__device__ __forceinline__ void kload8(bf16x8*kf,lds_cptr kp){
  kf[0]=*(const __attribute__((address_space(3))) bf16x8*)(kp);      kf[1]=*(const __attribute__((address_space(3))) bf16x8*)(kp+512);
  kf[2]=*(const __attribute__((address_space(3))) bf16x8*)(kp+2048); kf[3]=*(const __attribute__((address_space(3))) bf16x8*)(kp+2560);
  kf[4]=*(const __attribute__((address_space(3))) bf16x8*)(kp+4096); kf[5]=*(const __attribute__((address_space(3))) bf16x8*)(kp+4608);
  kf[6]=*(const __attribute__((address_space(3))) bf16x8*)(kp+6144); kf[7]=*(const __attribute__((address_space(3))) bf16x8*)(kp+6656);
}
__device__ __forceinline__ void kload2(bf16x8*kf,lds_cptr kp,int j){ kf[2*j]=*(const __attribute__((address_space(3))) bf16x8*)(kp+j*2048); kf[2*j+1]=*(const __attribute__((address_space(3))) bf16x8*)(kp+j*2048+512); }
__device__ __forceinline__ s16x4 vtr(lds_cptr p){ return __builtin_bit_cast(s16x4,__builtin_amdgcn_ds_read_tr16_b64_v4i16((__attribute__((address_space(3))) v4i16_t*)p)); }
__device__ __forceinline__ float rowmax(const f32x16&p0,const f32x16&p1){
  float a=max3f(p0[0],p0[1],p1[0]),b=max3f(p0[2],p0[3],p1[1]);a=max3f(a,p1[2],p1[3]);
  #pragma unroll
  for(int r=4;r<16;r+=4){a=max3f(a,p0[r],p0[r+1]);b=max3f(b,p0[r+2],p0[r+3]);a=max3f(a,p1[r],p1[r+1]);b=max3f(b,p1[r+2],p1[r+3]);}
  const float m=max2f(a,b);
  auto rr=__builtin_amdgcn_permlane32_swap(__float_as_uint(m),__float_as_uint(m),false,false);
  return max2f(__uint_as_float(rr[0]),__uint_as_float(rr[1]));
}
__device__ __forceinline__ void pv(f32x16*o,int vb,bf16x8 pa0,bf16x8 pa1,bf16x8 pa2,bf16x8 pa3){
  #pragma unroll
  for(int d0=0;d0<2;++d0){s16x4 lo[4],hi[4];
    #pragma unroll
    for(int ks=0;ks<4;++ks){
      asm volatile("ds_read_b64_tr_b16 %0,%1 offset:%c2":"=&v"(lo[ks]):"v"(vb),"i"(d0*4096+ks*1024):"memory");
      asm volatile("ds_read_b64_tr_b16 %0,%1 offset:%c2":"=&v"(hi[ks]):"v"(vb),"i"(d0*4096+ks*1024+512):"memory");}
    asm volatile("s_waitcnt lgkmcnt(0)":::"memory");SBAR();
    #define PK(k) (bf16x8){lo[k][0],lo[k][1],lo[k][2],lo[k][3],hi[k][0],hi[k][1],hi[k][2],hi[k][3]}
    o[d0]=__builtin_amdgcn_mfma_f32_32x32x16_bf16(pa0,PK(0),o[d0],0,0,0);
    o[d0]=__builtin_amdgcn_mfma_f32_32x32x16_bf16(pa1,PK(1),o[d0],0,0,0);
    o[d0]=__builtin_amdgcn_mfma_f32_32x32x16_bf16(pa2,PK(2),o[d0],0,0,0);
    o[d0]=__builtin_amdgcn_mfma_f32_32x32x16_bf16(pa3,PK(3),o[d0],0,0,0);
    #undef PK
  }
}

constexpr int ATTN_LDS_BYTES=LDS_BYTES;
struct AttnUnit { int bh; int qb; };
struct StaticOrder {
  int vcu, G;
  __device__ __forceinline__ explicit StaticOrder(int grid,int block):vcu((grid%8==0)?(block%8)*(grid/8)+block/8:block),G(grid){}
  __device__ __forceinline__ bool next(int i,AttnUnit&u)const{
    if(G==256){ if(i>=4)return false; const int s=vcu&7; u.bh=vcu>>3; u.qb=(i==0)?s:(i==1)?15-s:(i==2)?16+s:31-s; return true; }
    const int L=i*G+vcu; if(L>=BATCH*NHEAD*NQB)return false; u.bh=L/NQB; u.qb=NQB-1-(L%NQB); return true; }
};
struct DArgs { const float* in[25]; float* out; unsigned char* ws; int ph_lo, ph_hi; };
typedef const __attribute__((address_space(4))) DArgs* DArgsP;
__device__ __forceinline__ DArgsP dargs(){ DArgsP p=(DArgsP)__builtin_amdgcn_kernarg_segment_ptr(); asm volatile("":"+s"(p)); return p; }
constexpr int SLOTV=16384;
constexpr int AQ_WORD0=12288;
constexpr int L2_K=0, L2_V=NSLOT*SLOTB, L2_WS=L2_V+NSLOT*SLOTV, L2_TMP=L2_WS+NW*64*4, L2_LAM=L2_TMP+NW*8192, L2_BYTES=L2_LAM+64;
template<int DUMMY> __device__ __forceinline__ void attn_pass2(const bf16*Qh,const bf16*__restrict__ Kh,const bf16*__restrict__ Vh,const int q0,char*shm,f32x16 (&o)[4]){
  const int tid=ltid(),lane=tid&63,r32=lane&31,hi=lane>>5; const int wid=__builtin_amdgcn_readfirstlane(tid>>6);
  const bf16*Qw=Qh+(long)(q0+wid*QBLK)*DM;
  const unsigned lds0=(unsigned)(uintptr_t)shm;
  float*wsf=(float*)(shm+L2_WS)+wid*64;
  const bf16*ksrc=Kh+(long)lane*DM+wid*8;
  const bf16*vsrc=Vh+(long)(16*(wid&3)+(lane>>2))*DM+(wid>>2)*32+(lane&3)*8;
  const unsigned kdst=lds0+L2_K+wid*1024, vdst=lds0+L2_V+wid*1024;
  #define DMA_K(t,slot) glds16(ksrc+(long)(t)*KVBLK*DM,(unsigned)__builtin_amdgcn_readfirstlane(kdst+(slot)))
  #define DMA_V(t,slot) do{ glds16(vsrc+(long)(t)*KVBLK*DM,(unsigned)__builtin_amdgcn_readfirstlane(vdst+2*(slot))); glds16(vsrc+(long)(t)*KVBLK*DM+64,(unsigned)__builtin_amdgcn_readfirstlane(vdst+2*(slot)+8192)); }while(0)
  const char*Kbase=shm+L2_K; bf16x8 kf[8];
  const lds_cptr shm3=(lds_cptr)shm; const lds_cptr kp0=shm3+L2_K+hi*1024+r32*16; const lds_cptr vp0=shm3+L2_V+((lane>>4)&1)*32+(lane&3)*8+(4*hi+((lane&15)>>2))*64;
  const int NT=(q0+QB)/KVBLK;
  DMA_K(0,0);DMA_V(0,0);DMA_K(1,SLOTB);
  bf16x8 qr[4];
  #pragma unroll
  for(int d0=0;d0<4;++d0)qr[d0]=*reinterpret_cast<const bf16x8*>(&Qw[(long)r32*DM+d0*16+hi*8]);
  float l_reg=0.f;o[0]=f32x16{};o[1]=f32x16{};o[2]=f32x16{};o[3]=f32x16{};
  const f32x16 zero16=f32x16{};
  const int qrel=wid*QBLK+r32;
  #define CMASK(P0,P1,t) do{int jb_=(t)-(NT-4); if(jb_>=0)cmask(P0,P1,jb_,qrel,hi);}while(0)
  f32x16 pA0,pA1,pB0,pB1;
  int sl_prev=0,sl_cur=0,sl_next=SLOTB;
  #define ROT() do{sl_prev=sl_cur;sl_cur=sl_next;sl_next=(sl_next==(NSLOT-1)*SLOTB)?0:sl_next+SLOTB;}while(0)
  DMA_K(2,2*SLOTB);
  WAIT_BAR(4);
  qkt(pA0,pA1,Kbase,qr,zero16,r32,hi);CMASK(pA0,pA1,0);
  _Pragma("unroll") for(int r=0;r<16;++r){pA0[r]=__builtin_amdgcn_exp2f(pA0[r]);pA1[r]=__builtin_amdgcn_exp2f(pA1[r]);}
  WAIT_BAR(0);
  DMA_K(3,0);DMA_V(1,SLOTB);
  ROT();
  kload8(kf,kp0+sl_cur);
  WAIT_BAR(3);
  s16x4 vlo[8],vhi[8]; u32x4 pw0,pw1,pw2,pw3;
  #define PKW(P,B) cvtpk_s(P[B],P[B+1])
  #define PAF(k) __builtin_bit_cast(bf16x8,pw##k)
  #define VFR(i) (bf16x8){vlo[i][0],vlo[i][1],vlo[i][2],vlo[i][3],vhi[i][0],vhi[i][1],vhi[i][2],vhi[i][3]}
  #define PIN(x) asm volatile("":"+v"(x))
  #define GAPA(MF,A0,A1,A2,A3,W0,W1,PW) do{ MF; sacc+=A0; sacc+=A1; sacc+=A2; sacc+=A3; PIN(sacc); W0; W1; PIN(PW); SBAR(); }while(0)
  #define EX(v) __builtin_amdgcn_exp2f(v)
  #define GAPB(MF,X,B) do{ MF; X[B]=EX(X[B]); X[B+1]=EX(X[B+1]); PIN(X); SBAR(); }while(0)
  #define FOFF(d,ks) ((((d)>>1)*8192)+(((d)&1)*4096)+((ks)*1024))
  #define VRD(d,ks) do{ vlo[2*(d)+((ks)&1)]=vtr(vp_+FOFF(d,ks)); vhi[2*(d)+((ks)&1)]=vtr(vp_+(FOFF(d,ks)+512)); }while(0)
  #define VRH(d,ks) do{ VRD(d,ks); SBAR(); }while(0)
  #define VF(d,ks) VFR(2*(d)+((ks)&1))
  #define KRD(G,j) do{ if(G){ kload2(kf,kp0+sl_next,j); SBAR(); } }while(0)
  #define MF32(a,b,c) __builtin_amdgcn_mfma_f32_32x32x16_bf16(a,b,c,0,0,0)
  #define STEP(C0,C1,P0,P1,t,GK,GV,GL) do{ SBAR(); \
    const lds_cptr vp_=vp0+2*sl_prev; \
    VRD(0,0); SBAR(); float sacc=(P0[0]+P0[1]); \
    GAPA(C0=MF32(kf[0],qr[0],zero16), P0[2],P0[3],P0[4],P0[5],     pw0[0]=PKW(P0,0), pw0[1]=PKW(P0,2), pw0); \
    VRD(1,0); SBAR(); GAPA(C1=MF32(kf[1],qr[0],zero16), P0[6],P0[7],P0[8],P0[9],     pw0[2]=PKW(P0,4), pw0[3]=PKW(P0,6), pw0); \
    VRD(2,0); SBAR(); GAPA(C0=MF32(kf[2],qr[1],C0),   P0[10],P0[11],P0[12],P0[13], pw1[0]=PKW(P0,8), pw1[1]=PKW(P0,10), pw1); \
    VRD(3,0); SBAR(); GAPA(C1=MF32(kf[3],qr[1],C1),   P0[14],P0[15],P1[0],P1[1],   pw1[2]=PKW(P0,12),pw1[3]=PKW(P0,14), pw1); \
    VRD(0,1); SBAR(); GAPA(C0=MF32(kf[4],qr[2],C0),   P1[2],P1[3],P1[4],P1[5],     pw2[0]=PKW(P1,0), pw2[1]=PKW(P1,2), pw2); \
    VRD(1,1); SBAR(); GAPA(C1=MF32(kf[5],qr[2],C1),   P1[6],P1[7],P1[8],P1[9],     pw2[2]=PKW(P1,4), pw2[3]=PKW(P1,6), pw2); \
    VRD(2,1); SBAR(); GAPA(C0=MF32(kf[6],qr[3],C0),   P1[10],P1[11],P1[12],P1[13], pw3[0]=PKW(P1,8), pw3[1]=PKW(P1,10), pw3); \
    VRD(3,1); SBAR(); GAPA(C1=MF32(kf[7],qr[3],C1),   P1[14],P1[15],0.f,0.f,       pw3[2]=PKW(P1,12),pw3[3]=PKW(P1,14), pw3); \
    l_reg+=sacc; \
    if(GK){DMA_K((t)+3,sl_cur);} if(GV){DMA_V((t)+1,sl_next);} \
    CMASK(C0,C1,t); \
    SBAR(); \
    GAPB(o[0]=MF32(PAF(0),VF(0,0),o[0]), C0,0);  VRH(0,2); \
    GAPB(o[1]=MF32(PAF(0),VF(1,0),o[1]), C0,2);  VRH(1,2); \
    GAPB(o[2]=MF32(PAF(0),VF(2,0),o[2]), C0,4);  VRH(2,2); \
    GAPB(o[3]=MF32(PAF(0),VF(3,0),o[3]), C0,6);  VRH(3,2); \
    GAPB(o[0]=MF32(PAF(1),VF(0,1),o[0]), C0,8);  VRH(0,3); \
    GAPB(o[1]=MF32(PAF(1),VF(1,1),o[1]), C0,10); VRH(1,3); \
    GAPB(o[2]=MF32(PAF(1),VF(2,1),o[2]), C0,12); VRH(2,3); \
    GAPB(o[3]=MF32(PAF(1),VF(3,1),o[3]), C0,14); VRH(3,3); \
    GAPB(o[0]=MF32(PAF(2),VF(0,2),o[0]), C1,0); \
    GAPB(o[1]=MF32(PAF(2),VF(1,2),o[1]), C1,2); \
    KRD(GL,0); GAPB(o[2]=MF32(PAF(2),VF(2,2),o[2]), C1,4); \
    KRD(GL,1); GAPB(o[3]=MF32(PAF(2),VF(3,2),o[3]), C1,6); \
    KRD(GL,2); GAPB(o[0]=MF32(PAF(3),VF(0,3),o[0]), C1,8); \
    KRD(GL,3); GAPB(o[1]=MF32(PAF(3),VF(1,3),o[1]), C1,10); \
    GAPB(o[2]=MF32(PAF(3),VF(2,3),o[2]), C1,12); \
    GAPB(o[3]=MF32(PAF(3),VF(3,3),o[3]), C1,14); \
    }while(0)
  int t=1;
  #undef CMASK
  #define CMASK(P0,P1,t) do{}while(0)
  for(;t+5<NT;t+=2){
    STEP(pB0,pB1,pA0,pA1,t,true,true,true);     WAIT_BAR(3); ROT();
    STEP(pA0,pA1,pB0,pB1,t+1,true,true,true);   WAIT_BAR(3); ROT();
  }
  #undef CMASK
  #define CMASK(P0,P1,t) do{int jb_=(t)-(NT-4); if(jb_>=0)cmask(P0,P1,jb_,qrel,hi);}while(0)
  #define ENDW(tt) do{ if((tt)+3<NT){WAIT_BAR(3);} else if((tt)+2<NT){WAIT_BAR(2);} else {WAIT_BAR(0);} }while(0)
  for(;t+1<NT;t+=2){
    STEP(pB0,pB1,pA0,pA1,t,(t+3<NT),(t+1<NT),(t+1<NT));       ENDW(t);   ROT();
    STEP(pA0,pA1,pB0,pB1,t+1,(t+4<NT),(t+2<NT),(t+2<NT));     ENDW(t+1); ROT();
  }
  STEP(pB0,pB1,pA0,pA1,NT-1,false,false,false);
  { float sacc=pB0[0]+pB0[1]; _Pragma("unroll") for(int r=2;r<16;++r)sacc+=pB0[r]; _Pragma("unroll") for(int r=0;r<16;++r)sacc+=pB1[r]; l_reg+=sacc;
    pw0=(u32x4){PKW(pB0,0),PKW(pB0,2),PKW(pB0,4),PKW(pB0,6)};pw1=(u32x4){PKW(pB0,8),PKW(pB0,10),PKW(pB0,12),PKW(pB0,14)};pw2=(u32x4){PKW(pB1,0),PKW(pB1,2),PKW(pB1,4),PKW(pB1,6)};pw3=(u32x4){PKW(pB1,8),PKW(pB1,10),PKW(pB1,12),PKW(pB1,14)};
    SBAR();
    const lds_cptr vq=vp0+2*sl_cur;
    #pragma unroll
    for(int d0=0;d0<4;++d0){ bf16x8 vf[4];
      #pragma unroll
      for(int ks=0;ks<4;++ks){ const s16x4 lo=vtr(vq+(d0*4096+ks*1024)), h2=vtr(vq+(d0*4096+ks*1024+512)); vf[ks]=(bf16x8){lo[0],lo[1],lo[2],lo[3],h2[0],h2[1],h2[2],h2[3]}; }
      o[d0]=MF32(PAF(0),vf[0],o[d0]); o[d0]=MF32(PAF(1),vf[1],o[d0]); o[d0]=MF32(PAF(2),vf[2],o[d0]); o[d0]=MF32(PAF(3),vf[3],o[d0]); } }
  #undef PKW
  #undef PAF
  #undef VFR
  #undef PIN
  #undef GAPA
  #undef GAPB
  #undef EX
  #undef VRD
  #undef VRH
  #undef VF
  #undef FOFF
  #undef KRD
  #undef STEP
  #undef ENDW
  #undef MF32
  {auto rr=__builtin_amdgcn_permlane32_swap(__float_as_uint(l_reg),__float_as_uint(l_reg),false,false);l_reg=__uint_as_float(rr[0])+__uint_as_float(rr[1]);}
  if(hi==0)wsf[32+r32]=l_reg;asm volatile("s_waitcnt lgkmcnt(0)":::"memory");
  #pragma unroll
  for(int r=0;r<16;++r){const float rl=__builtin_amdgcn_rcpf(wsf[32+crow(r,hi)]); o[0][r]*=rl;o[1][r]*=rl;o[2][r]*=rl;o[3][r]*=rl;}
  asm volatile("s_waitcnt lgkmcnt(0)\n\ts_barrier":::"memory");
  #undef DMA_K
  #undef DMA_V
  #undef CMASK
  #undef ROT
}
template<int DUMMY> __device__ __forceinline__ void dattn_phase2(const int l,char*shm,const size_t ws_qkv,const size_t ws_o){
  { const int tid0=ltid(); const int lane=tid0&63; const int j=l>>1; DArgsP ap=dargs();
    float s1=ap->in[12][j*64+lane]*ap->in[13][j*64+lane], s2=ap->in[14][j*64+lane]*ap->in[15][j*64+lane];
    #pragma unroll
    for(int o_=1;o_<64;o_<<=1){s1+=__shfl_xor(s1,o_);s2+=__shfl_xor(s2,o_);}
    const float lam_init=0.8f-0.6f*expf(-0.3f*(float)l); const float lam=expf(s1)-expf(s2)+lam_init;
    if(tid0==0){ float*lw=(float*)(shm+L2_LAM); lw[0]=lam; lw[1]=1.0f-lam_init; }
    asm volatile("s_waitcnt lgkmcnt(0)\n\ts_barrier":::"memory"); }
  for(int it=0;;++it){
    const int tid=ltid(),lane=tid&63,r32=lane&31,hi=lane>>5; const int wid=__builtin_amdgcn_readfirstlane(tid>>6);
    const StaticOrder S(lgrid(),lbid()); AttnUnit u; if(!S.next(it>>1,u))break;
    const int c=it&1; const int b=u.bh/NHEAD,h=u.bh%NHEAD; const int q0=u.qb*QB;
    unsigned*tmpw=(unsigned*)(shm+L2_TMP)+wid*2048; bf16*stg=(bf16*)tmpw;
    f32x16 o[4];
    { DArgsP ap=dargs(); const bf16*base=(const bf16*)(ap->ws+ws_qkv)+(long)b*SEQ*DM;
      attn_pass2<0>(base+h*128+c*64,base+1024+h*128+c*64,base+2048+h*128,q0,shm,o); }
    if(c==0){
      #pragma unroll
      for(int d=0;d<4;++d){
        #pragma unroll
        for(int r=0;r<16;r+=2)tmpw[(d*8+(r>>1))*64+lane]=cvtpk_s(o[d][r],o[d][r+1]);}
    }else{
      unsigned t[32];
      #pragma unroll
      for(int k=0;k<32;++k)t[k]=tmpw[k*64+lane];
      const float lam=*((const float*)(shm+L2_LAM));
      asm volatile("s_waitcnt lgkmcnt(0)":::"memory");
      #pragma unroll
      for(int r=0;r<16;r+=2){const int orow0=crow(r,hi),orow1=crow(r+1,hi);
        #pragma unroll
        for(int d=0;d<4;++d){ const unsigned w=t[d*8+(r>>1)];
          stg[orow0*128+d*32+r32]=__float2bfloat16(__uint_as_float(w<<16)-lam*o[d][r]);
          stg[orow1*128+d*32+r32]=__float2bfloat16(__uint_as_float(w&0xffff0000u)-lam*o[d][r+1]);}}
      asm volatile("s_waitcnt lgkmcnt(0)":::"memory");
      DArgsP ap=dargs(); const int j=l>>1; const float osc=*((const float*)(shm+L2_LAM+4));
      const int ch=lane&15; const float*subln=ap->in[16]+j*128;
      float gn[8];
      #pragma unroll
      for(int k=0;k<8;++k)gn[k]=subln[ch*8+k]*osc;
      bf16*Ow=(bf16*)(ap->ws+ws_o)+((long)b*SEQ+q0+wid*QBLK)*OPITCH+h*128+ch*8;
      #pragma unroll
      for(int i=0;i<8;++i){const int row=i*4+(lane>>4);
        const u32x4 v=*(const u32x4*)(stg+row*128+ch*8);
        float f[8]; f[0]=__uint_as_float(v.x<<16);f[1]=__uint_as_float(v.x&0xffff0000u);f[2]=__uint_as_float(v.y<<16);f[3]=__uint_as_float(v.y&0xffff0000u);
        f[4]=__uint_as_float(v.z<<16);f[5]=__uint_as_float(v.z&0xffff0000u);f[6]=__uint_as_float(v.w<<16);f[7]=__uint_as_float(v.w&0xffff0000u);
        float ss=0.f;
        #pragma unroll
        for(int k=0;k<8;++k)ss+=f[k]*f[k];
        ss+=__shfl_xor(ss,1);ss+=__shfl_xor(ss,2);ss+=__shfl_xor(ss,4);ss+=__shfl_xor(ss,8);
        const float rstd=rsqrtf(ss*(1.0f/128.0f)+1e-6f);
        u32x4 w; w.x=cvtpk_s(f[0]*rstd*gn[0],f[1]*rstd*gn[1]); w.y=cvtpk_s(f[2]*rstd*gn[2],f[3]*rstd*gn[3]); w.z=cvtpk_s(f[4]*rstd*gn[4],f[5]*rstd*gn[5]); w.w=cvtpk_s(f[6]*rstd*gn[6],f[7]*rstd*gn[7]);
        *(u32x4*)(Ow+(long)row*OPITCH)=w; }
    }
    asm volatile("s_waitcnt lgkmcnt(0)":::"memory");
  }
}

#undef SBAR
#undef WAIT_BAR
}
#define GAS __attribute__((address_space(1)))
#define LAS __attribute__((address_space(3)))
typedef unsigned short bf16;
typedef unsigned v4u __attribute__((ext_vector_type(4)));
typedef unsigned v2u __attribute__((ext_vector_type(2)));
typedef float f32x4 __attribute__((ext_vector_type(4)));
typedef float f32x2 __attribute__((ext_vector_type(2)));
typedef short bf16x8 __attribute__((ext_vector_type(8)));
constexpr int NWAVES = 8;
constexpr int BATCH = 4, SEQ = 8192, D = 1024, M = BATCH * SEQ, DFF = 2816, DEPTH = 4, GH = 2048;
constexpr size_t MiB = 1u << 20;
constexpr size_t WS_WSB = 1 * MiB, WS_PART = 2 * MiB, WS_STATS = 4 * MiB, WS_WFFN = 12 * MiB, WS_WMIX = 144 * MiB, WS_XB = 184 * MiB, WS_ACT = 256 * MiB, WS_O = 448 * MiB, WS_END = 512 * MiB;
constexpr size_t FFN_STRIDE = 16 * MiB + MiB / 2, FFN_DOWN_OFF = 11 * MiB;
#define MIX_OFF(l) ((size_t)((l) >> 1) * (20 * MiB) + (size_t)((l) & 1) * (8 * MiB))
constexpr int XBP = 1024;
static_assert(WS_XB + (size_t)32768 * XBP * 2 <= 256 * MiB && WS_WMIX + 40 * MiB <= WS_XB, "d_ws map (XB)");
constexpr int RING_BYTES = 131072, RS_OFF = RING_BYTES, RS_BYTES = 16 * 1024, LDS_BYTES = 150528;
static_assert(attn_body::L2_BYTES <= LDS_BYTES && RS_OFF + RS_BYTES <= LDS_BYTES, "LDS map");
constexpr int NPHASE = 1 + 7 * DEPTH;
constexpr size_t ZV_OFF = (size_t)256 * 8 * 32768;

__device__ __forceinline__ float wave_sum(float v) {
#pragma unroll
    for (int o = 1; o < 64; o <<= 1) v += __shfl_xor(v, o);
    return v;
}
__device__ __forceinline__ unsigned f2bf(float f) { unsigned u = __builtin_bit_cast(unsigned, f); return (u + 0x7fffu + ((u >> 16) & 1u)) >> 16; }
__device__ __forceinline__ unsigned pk2(float lo, float hi) { return pg8::cvt_pk_bf16(lo, hi); }
__device__ __forceinline__ float bflo(unsigned w) { return __uint_as_float(w << 16); }
__device__ __forceinline__ float bfhi(unsigned w) { return __uint_as_float(w & 0xffff0000u); }

template <int MODE> __device__ __forceinline__ int map_row(int n) {
    if (MODE == 1) { const int up = n >= DFF ? 1 : 0; const int f = n - up * DFF; return (f >> 7) * 256 + up * 128 + (f & 127); }
    if (MODE == 2) { const int t = n & 255; return (n & ~255) + ((t >> 5) & 1) * 128 + (t >> 6) * 32 + (t & 31); }
    return n;
}
template <int MODE> __device__ __forceinline__ void transpose_item(const float* W, int K, int N, bf16* WT, const float* gain, LAS float* scr, int item, int lane) {
    const int nblk = N / 32, kb = item / nblk, nb = item % nblk, k0 = 64 * kb, n0 = 32 * nb;
    float wv[32];
#pragma unroll
    for (int i = 0; i < 32; ++i) { const int kk = 2 * i + (lane >> 5); wv[i] = W[(size_t)(k0 + kk) * N + n0 + (lane & 31)]; }
    const float gl = gain ? gain[k0 + lane] : 1.0f;
#pragma unroll
    for (int i = 0; i < 32; ++i) { const int kk = 2 * i + (lane >> 5); scr[kk * 33 + (lane & 31)] = wv[i] * __shfl(gl, kk); }
    asm volatile("s_waitcnt lgkmcnt(0)" ::: "memory");
    const int c = lane & 7;
#pragma unroll
    for (int j = 0; j < 4; ++j) { const int n = (lane >> 3) + 8 * j; const LAS float* s = scr + (8 * c) * 33 + n;
        v4u o; o.x = pk2(s[0 * 33], s[1 * 33]); o.y = pk2(s[2 * 33], s[3 * 33]); o.z = pk2(s[4 * 33], s[5 * 33]); o.w = pk2(s[6 * 33], s[7 * 33]);
        *(v4u*)(WT + (size_t)map_row<MODE>(n0 + n) * K + k0 + 8 * c) = o; }
    asm volatile("s_waitcnt lgkmcnt(0)" ::: "memory");
}
template <int MODE> __device__ __forceinline__ void transpose_job(const float* W, int K, int N, bf16* WT, const float* gain, LAS float* scr, int lane, int gw, int NGW, int& cum) {
    const int nitems = (K / 64) * (N / 32);
    int first = (gw - (cum % NGW)); if (first < 0) first += NGW;
    for (int it = first; it < nitems; it += NGW) transpose_item<MODE>(W, K, N, WT, gain, scr, it, lane);
    cum += nitems;
}

struct Args { const float* in[25]; float* out; unsigned char* ws; int ph_lo, ph_hi; };

typedef const __attribute__((address_space(4))) Args* ArgsP;
__device__ __forceinline__ void prologue(ArgsP ap, LAS unsigned char* lds, int wave, int lane, int vcu, int G) {
    LAS float* scr = (LAS float*)(lds + wave * 16384);
    const int gw = vcu * NWAVES + wave, NGW = G * NWAVES;
    unsigned char* ws = ap->ws; int cum = 0;
    for (int l = 0; l < DEPTH; ++l) {
        for (int f = 0; f < 2; ++f) {
            const float* nrm = (f ? ap->in[5] : ap->in[1]) + (size_t)l * D; const float* wgu = (f ? ap->in[6] : ap->in[2]) + (size_t)l * D * 2 * DFF; const float* wd = (f ? ap->in[7] : ap->in[3]) + (size_t)l * DFF * D;
            bf16* dst = (bf16*)(ws + WS_WFFN + (size_t)(l * 2 + f) * FFN_STRIDE);
            transpose_job<1>(wgu, D, 2 * DFF, dst, nrm, scr, lane, gw, NGW, cum);
            transpose_job<0>(wd, DFF, D, (bf16*)((unsigned char*)dst + FFN_DOWN_OFF), nullptr, scr, lane, gw, NGW, cum);
        }
        const int j = l >> 1; bf16* mdst = (bf16*)(ws + WS_WMIX + MIX_OFF(l)); const float* mn = ap->in[4] + (size_t)l * D;
        if ((l & 1) == 0) {
            transpose_job<2>(ap->in[8] + (size_t)j * D * 3072, D, 3072, mdst, mn, scr, lane, gw, NGW, cum);
            transpose_job<0>(ap->in[9] + (size_t)j * D * D, D, D, (bf16*)((unsigned char*)mdst + 6 * MiB), nullptr, scr, lane, gw, NGW, cum);
        } else {
            transpose_job<0>(ap->in[17] + (size_t)j * D * 4096, D, 4096, mdst, mn, scr, lane, gw, NGW, cum);
            transpose_job<0>(ap->in[23] + (size_t)j * GH * D, GH, D, (bf16*)((unsigned char*)mdst + 8 * MiB), nullptr, scr, lane, gw, NGW, cum);
        }
    }
    { const float* wsrc = ap->in[21]; bf16* wdst = (bf16*)(ws + WS_WSB); const int gt = gw * 64 + lane, NT = NGW * 64;
      for (int i = gt; i < 2 * 8 * 128 * 128; i += NT) { const int s = i & 127, t = (i >> 7) & 127; wdst[i] = (bf16)f2bf(s <= t ? wsrc[i] : 0.0f); } }
    { const float* x = ap->in[0]; bf16* xb = (bf16*)(ws + WS_XB); float* part = (float*)(ws + WS_PART);
      for (int m0 = gw; m0 < M; m0 += 2 * NGW) {
          const int m1 = m0 + NGW; const f32x4* xr0 = (const f32x4*)(x + (size_t)m0 * D) + lane; const f32x4* xr1 = (const f32x4*)(x + (size_t)m1 * D) + lane; f32x4 v0[4], v1[4]; float s0 = 0.f, s1 = 0.f;
#pragma unroll
          for (int j = 0; j < 4; ++j) { v0[j] = xr0[64 * j]; v1[j] = xr1[64 * j]; }
#pragma unroll
          for (int j = 0; j < 4; ++j) { s0 += (v0[j][0] * v0[j][0] + v0[j][1] * v0[j][1]) + (v0[j][2] * v0[j][2] + v0[j][3] * v0[j][3]); s1 += (v1[j][0] * v1[j][0] + v1[j][1] * v1[j][1]) + (v1[j][2] * v1[j][2] + v1[j][3] * v1[j][3]); }
#pragma unroll
          for (int o = 1; o < 64; o <<= 1) { s0 += __shfl_xor(s0, o); s1 += __shfl_xor(s1, o); }
          v2u* o80 = (v2u*)(xb + (size_t)m0 * XBP) + lane; v2u* o81 = (v2u*)(xb + (size_t)m1 * XBP) + lane;
#pragma unroll
          for (int j = 0; j < 4; ++j) { o80[64 * j] = (v2u){pk2(v0[j][0], v0[j][1]), pk2(v0[j][2], v0[j][3])}; o81[64 * j] = (v2u){pk2(v1[j][0], v1[j][1]), pk2(v1[j][2], v1[j][3])}; }
          if (lane < 16) { part[(size_t)m0 * 16 + lane] = lane == 0 ? s0 : 0.f; part[(size_t)m1 * 16 + lane] = lane == 0 ? s1 : 0.f; } } }
}

__device__ __forceinline__ void fill_rs(LAS float* rs, const float* part, const pg8::StaticOrder& S, int tid, LAS float* aux = nullptr, const float* bias = nullptr, const float* qg = nullptr, const float* kg = nullptr, float qscale = 1.f) {
    pg8::Unit u;
    if (qg) { if (tid < 64) aux[tid] = qg[tid] * qscale; else if (tid < 128) aux[tid] = kg[tid - 64]; }
    for (int i0 = 0; ; i0 += 2) { const int i = i0 + (tid >> 8);
        if (!S.next(i0, u)) break;
        if (S.next(i, u)) { const int row = u.pm * 256 + (tid & 255); const f32x4* p = (const f32x4*)(part + (size_t)row * 16); const f32x4 a = p[0], b = p[1], c = p[2], d = p[3];
            const float s = (((a[0] + a[1]) + (a[2] + a[3])) + ((b[0] + b[1]) + (b[2] + b[3]))) + (((c[0] + c[1]) + (c[2] + c[3])) + ((d[0] + d[1]) + (d[2] + d[3])));
            rs[i * 256 + (tid & 255)] = rsqrtf(s * (1.0f / 1024.0f) + 1e-6f);
            if (bias) aux[i * 256 + (tid & 255)] = bias[u.pn * 256 + (tid & 255)]; } }
    __syncthreads();
}

__device__ __forceinline__ void sgu_phase(LAS unsigned char* lds, bf16* Z, const float* stats, const bf16* wsb, const float* lng, const float* lnb, const float* bs, int G, int c) {
    const int tid = ltid(), lane = tid & 63, wid = __builtin_amdgcn_readfirstlane(tid >> 6), wr = wid >> 2, wc = wid & 3, fr = lane & 15, fq = lane >> 4;
    LAS bf16* VT = (LAS bf16*)lds;
    LAS bf16* WL = (LAS bf16*)(lds + 69632);
    LAS float* MR = (LAS float*)(lds + 69632 + 34816);
    LAS float* GB = (LAS float*)(lds + 69632 + 34816 + 1024);
    for (int ck = c; ck < 256; ck += G) {
        const size_t row0 = (size_t)ck * 128;
        { const f32x4* sp = (const f32x4*)(stats + (row0 + (tid >> 2)) * 64) + (tid & 3) * 4; float s = 0.f, q = 0.f;
#pragma unroll
          for (int j = 0; j < 4; ++j) { const f32x4 v = sp[j]; s += v[0] + v[2]; q += v[1] + v[3]; }
          s += __shfl_xor(s, 1); s += __shfl_xor(s, 2); q += __shfl_xor(q, 1); q += __shfl_xor(q, 2);
          if ((tid & 3) == 0) { const float mean = s * (1.0f / 2048.0f); const float var = fmaxf(q * (1.0f / 2048.0f) - mean * mean, 0.f); MR[(tid >> 2) * 2] = mean; MR[(tid >> 2) * 2 + 1] = rsqrtf(var + 1e-5f); } }
        v4u vraw[8];
        const bf16* vb = Z + ZV_OFF + (size_t)ck * 8 * 32768 + (tid & 127) * 256 + (tid >> 7) * 8;
#define SGU_LOADVW(g_) do { _Pragma("unroll") for (int j = 0; j < 8; ++j) vraw[j] = *(const v4u*)(vb + (size_t)(g_) * 32768 + j * 32); } while (0)
        SGU_LOADVW(0);
        for (int g = 0; g < 8; ++g) {
            GB[tid] = tid < 256 ? lng[g * 256 + tid] : lnb[g * 256 + tid - 256];
            __syncthreads();
#pragma unroll
            for (int j = 0; j < 4; ++j) { const int p = tid + 512 * j, t = p >> 4, pc = p & 15; *(LAS v4u*)(WL + t * 136 + pc * 8) = *(const v4u*)(wsb + (size_t)g * 16384 + t * 128 + pc * 8); }
#pragma unroll
            for (int j = 0; j < 8; ++j) { const int s = tid & 127, cc = (tid >> 7) * 8 + 32 * j; const v4u raw = vraw[j];
                const float mean = MR[2 * s], rstd = MR[2 * s + 1];
                const f32x4 g0 = *(const LAS f32x4*)(GB + cc), g1 = *(const LAS f32x4*)(GB + cc + 4), b0 = *(const LAS f32x4*)(GB + 256 + cc), b1 = *(const LAS f32x4*)(GB + 256 + cc + 4);
                LAS bf16* d = VT + cc * 136 + s;
                d[0 * 136] = (bf16)f2bf((bflo(raw.x) - mean) * rstd * g0[0] + b0[0]); d[1 * 136] = (bf16)f2bf((bfhi(raw.x) - mean) * rstd * g0[1] + b0[1]);
                d[2 * 136] = (bf16)f2bf((bflo(raw.y) - mean) * rstd * g0[2] + b0[2]); d[3 * 136] = (bf16)f2bf((bfhi(raw.y) - mean) * rstd * g0[3] + b0[3]);
                d[4 * 136] = (bf16)f2bf((bflo(raw.z) - mean) * rstd * g1[0] + b1[0]); d[5 * 136] = (bf16)f2bf((bfhi(raw.z) - mean) * rstd * g1[1] + b1[1]);
                d[6 * 136] = (bf16)f2bf((bflo(raw.w) - mean) * rstd * g1[2] + b1[2]); d[7 * 136] = (bf16)f2bf((bfhi(raw.w) - mean) * rstd * g1[3] + b1[3]); }
            __syncthreads();
            v2u uu[4][4];
#pragma unroll
            for (int m = 0; m < 4; ++m) { const bf16* zr = Z + ((size_t)ck * 8 + g) * 32768 + (64 * wr + 16 * m + fr) * 256 + 64 * wc + 4 * fq;
#pragma unroll
                for (int n = 0; n < 4; ++n) uu[m][n] = *(const v2u*)(zr + 16 * n); }
            asm volatile("" ::: "memory");
            if (g < 7) SGU_LOADVW(g + 1);
            asm volatile("" ::: "memory");
            f32x4 acc[4][4];
#pragma unroll
            for (int m = 0; m < 4; ++m)
#pragma unroll
                for (int n = 0; n < 4; ++n) acc[m][n] = (f32x4){0.f, 0.f, 0.f, 0.f};
            const int kend = wr == 0 ? 2 : 4;
            for (int ks = 0; ks < kend; ++ks) { bf16x8 af[4], bfr[4];
#pragma unroll
                for (int m = 0; m < 4; ++m) af[m] = *(const LAS bf16x8*)(WL + (64 * wr + 16 * m + fr) * 136 + ks * 32 + fq * 8);
#pragma unroll
                for (int n = 0; n < 4; ++n) bfr[n] = *(const LAS bf16x8*)(VT + (64 * wc + 16 * n + fr) * 136 + ks * 32 + fq * 8);
#pragma unroll
                for (int m = 0; m < 4; ++m)
#pragma unroll
                    for (int n = 0; n < 4; ++n) acc[m][n] = __builtin_amdgcn_mfma_f32_16x16x32_bf16(bfr[n], af[m], acc[m][n], 0, 0, 0); }
#pragma unroll
            for (int m = 0; m < 4; ++m) { const int t = 64 * wr + 16 * m + fr; const float bsv = bs[g * 128 + t]; bf16* zr = Z + ((size_t)ck * 8 + g) * 32768 + t * 256 + 64 * wc + 4 * fq;
#pragma unroll
                for (int n = 0; n < 4; ++n) { const v2u u2 = uu[m][n]; const f32x4 a = acc[m][n];
                    *(v2u*)(zr + 16 * n) = (v2u){pk2(bflo(u2.x) * (a[0] + bsv), bfhi(u2.x) * (a[1] + bsv)), pk2(bflo(u2.y) * (a[2] + bsv), bfhi(u2.y) * (a[3] + bsv))}; } }
            __syncthreads();
        }
#undef SGU_LOADVW
    }
}

#define RLX_AGENT __ATOMIC_RELAXED, __HIP_MEMORY_SCOPE_AGENT
constexpr int MISC_OFF = 149632;
static_assert(attn_body::L2_BYTES <= MISC_OFF && MISC_OFF + 16 <= LDS_BYTES, "LDS map (barrier words)");
constexpr size_t WS_CTL = 0, CTL_ZERO_BYTES = 65536;
#define XB_TMO      128
#define XB_XCNT(j)  (256  + 64 * (j))
#define XB_XSUB(j)  (1280 + 64 * (j))
#define XB_XGEN(j)  (2304 + 64 * (j))
#define XB_TOP      3328
#define XB_TOPGEN   3392
#define XCD_BAR_WORDS 3456
#define XB_SPIN_CAP (1u << 18)

__device__ __forceinline__ unsigned xb_ld(unsigned* p)              { return __hip_atomic_load(p, __ATOMIC_RELAXED, __HIP_MEMORY_SCOPE_AGENT); }
__device__ __forceinline__ unsigned xb_add(unsigned* p, unsigned v) { return __hip_atomic_fetch_add(p, v, __ATOMIC_RELAXED, __HIP_MEMORY_SCOPE_AGENT); }
__device__ __forceinline__ unsigned xb_xcc_id() { return (unsigned)__builtin_amdgcn_s_getreg((3 << 11) | 20) & 0xFu; }
#define XB_SPIN(cond, bar) do { unsigned _sp = 0; while (cond) { __builtin_amdgcn_s_sleep(1); \
    if ((++_sp & 255u) == 0u) { if (xb_ld(&(bar)[XB_TMO])) break; if (_sp > XB_SPIN_CAP) { atomicAdd(&(bar)[XB_TMO], 1u); break; } } } } while (0)

struct XcdBarrier {
    unsigned* bar; unsigned x;
    volatile LAS unsigned* st;
};

__device__ __forceinline__ XcdBarrier xcd_barrier_post(unsigned* bar, volatile LAS unsigned* st) {
    XcdBarrier b; b.bar = bar; b.x = xb_xcc_id(); b.st = st;
    if (threadIdx.x == 0) (void)xb_add(&bar[XB_XCNT(b.x)], 1u);
    return b;
}
__device__ __forceinline__ void xcd_barrier_complete(unsigned* bar, unsigned x, unsigned& nloc, unsigned& nx) {
    const unsigned G = gridDim.x * gridDim.y * gridDim.z;
    unsigned sum, cnt, mine, sp = 0u;
    for (;;) {
        sum = 0u; cnt = 0u; mine = 0u;
#pragma unroll
        for (unsigned j = 0; j < 16; ++j) { const unsigned c = xb_ld(&bar[XB_XCNT(j)]); sum += c; cnt += (c > 0u) ? 1u : 0u; mine = (j == x) ? c : mine; }
        if (sum == G) break;
        __builtin_amdgcn_s_sleep(1);
        if ((++sp & 255u) == 0u) { if (xb_ld(&bar[XB_TMO])) break; if (sp > XB_SPIN_CAP) { atomicAdd(&bar[XB_TMO], 1u); break; } }
    }
    nloc = mine > 0u ? mine : 1u; nx = cnt > 0u ? cnt : 1u;
}

__device__ __forceinline__ void xcd_barrier(const XcdBarrier& b) {
    asm volatile("s_waitcnt vmcnt(0)" ::: "memory");
    __syncthreads();
    if (threadIdx.x == 0) {
        unsigned* bar = b.bar;
        __builtin_amdgcn_s_waitcnt(0);
        unsigned nloc = b.st[0], nx = b.st[1];
        if (nloc == 0u) { xcd_barrier_complete(bar, b.x, nloc, nx); b.st[0] = nloc; b.st[1] = nx; }
        const unsigned old = xb_add(&bar[XB_XSUB(b.x)], 1u);
        const unsigned gen = old / nloc;
        if (old + 1u == (gen + 1u) * nloc) {
            __builtin_amdgcn_fence(__ATOMIC_RELEASE, "agent");
            asm volatile("s_waitcnt vmcnt(0)" ::: "memory");
            const unsigned og = xb_add(&bar[XB_TOP], 1u);
            const unsigned tg = og / nx;
            if (og + 1u == (tg + 1u) * nx) xb_add(&bar[XB_TOPGEN], 1u);
            else XB_SPIN(xb_ld(&bar[XB_TOPGEN]) == tg, bar);
            __builtin_amdgcn_fence(__ATOMIC_ACQUIRE, "agent");
            xb_add(&bar[XB_XGEN(b.x)], 1u);
            asm volatile("s_waitcnt vmcnt(0)" ::: "memory");
        } else {
            XB_SPIN(xb_ld(&bar[XB_XGEN(b.x)]) == gen, bar);
            __builtin_amdgcn_fence(__ATOMIC_ACQUIRE, "agent");
            asm volatile("s_waitcnt vmcnt(0)" ::: "memory");
        }
    }
    __syncthreads();
}

__device__ __forceinline__ ArgsP kargs() { ArgsP p = (ArgsP)__builtin_amdgcn_kernarg_segment_ptr(); asm volatile("" : "+s"(p)); return p; }
__global__ void __launch_bounds__(NWAVES * 64, 2) fwd_kernel(Args a_) {
    extern __shared__ __attribute__((aligned(16))) unsigned char lds_raw[];
    const int ph_lo = kargs()->ph_lo;
    const bool one_launch = kargs()->ph_hi - ph_lo > 1;
    if (one_launch) { volatile LAS unsigned* st0 = (volatile LAS unsigned*)((LAS unsigned char*)lds_raw + MISC_OFF);
        if (threadIdx.x < 4) st0[threadIdx.x] = 0u;
        __syncthreads();
        (void)xcd_barrier_post((unsigned*)(kargs()->ws + WS_CTL), st0); }
    for (int st = ph_lo; ; ++st) {
        if (st == 0) {
            ArgsP ap = kargs(); LAS unsigned char* lds = (LAS unsigned char*)lds_raw;
            const int tid = ltid(), lane = tid & 63, wave = __builtin_amdgcn_readfirstlane(tid >> 6);
            const int G = lgrid(), bx = lbid(), vcu = (G % 8 == 0) ? (bx % 8) * (G / 8) + bx / 8 : bx;
            prologue(ap, lds, wave, lane, vcu, G);
        } else {
            const int l = (st - 1) / 7, ph = (st - 1) % 7; const bool attn = (l & 1) == 0;
            if (ph == 0 || ph == 5) {
                ArgsP ap = kargs(); LAS unsigned char* lds = (LAS unsigned char*)lds_raw; unsigned char* ws = ap->ws; const int G = lgrid(), bx = lbid();
                LAS float* rs = (LAS float*)(lds + RS_OFF);
                unsigned char* wffn = ws + WS_WFFN + (size_t)(l * 2 + (ph >= 5 ? 1 : 0)) * FFN_STRIDE;
                pg8::Gemm g{(const bf16*)(ws + WS_XB), (const bf16*)wffn, M, 2 * DFF, D, XBP, 0, 0}; pg8::StaticOrder S; S.init(M, 2 * DFF, G, bx);
                fill_rs(rs, (const float*)(ws + WS_PART), S, ltid());
                pg8::EpiSwiglu E{(bf16*)(ws + WS_ACT), rs, DFF};
                pg8::gemm_phase<pg8::EpiSwiglu, pg8::StaticOrder, true, true>(lds, g, S, E);
            } else if (ph == 1 || ph == 4 || ph == 6) {
                ArgsP ap = kargs(); LAS unsigned char* lds = (LAS unsigned char*)lds_raw; unsigned char* ws = ap->ws; const int G = lgrid(), bx = lbid(); const int j = l >> 1;
                unsigned char* wffn = ws + WS_WFFN + (size_t)(l * 2 + (ph >= 5 ? 1 : 0)) * FFN_STRIDE; unsigned char* wmix = ws + WS_WMIX + MIX_OFF(l);
                pg8::Gemm g; const float* bias = nullptr; float alpha = 1.f;
                if (ph != 4) { g = pg8::Gemm{(const bf16*)(ws + WS_ACT), (const bf16*)(wffn + FFN_DOWN_OFF), M, D, DFF, DFF, 0, 0}; alpha = 0.5f; }
                else if (attn) { g = pg8::Gemm{(const bf16*)(ws + WS_O), (const bf16*)(wmix + 6 * MiB), M, D, D, D, 0, 0}; }
                else { g = pg8::Gemm{(const bf16*)(ws + WS_ACT), (const bf16*)(wmix + 8 * MiB), M, D, GH, 256, (size_t)8 * 32768 * 2, (size_t)32768 * 2};     bias = ap->in[24] + (size_t)j * D; }
                pg8::StaticOrder S; S.init(M, D, G, bx);
                pg8::EpiResid E{ap->in[0], ap->out, (bf16*)(ws + WS_XB), (float*)(ws + WS_PART), bias, alpha, (st == 2) ? 1 : ((st == NPHASE - 1) ? 2 : 0)};
                pg8::gemm_phase<pg8::EpiResid, pg8::StaticOrder, true, true>(lds, g, S, E);
            } else if (ph == 2) {
                ArgsP ap = kargs(); LAS unsigned char* lds = (LAS unsigned char*)lds_raw; unsigned char* ws = ap->ws; const int G = lgrid(), bx = lbid(); const int j = l >> 1;
                LAS float* rs = (LAS float*)(lds + RS_OFF); unsigned char* wmix = ws + WS_WMIX + MIX_OFF(l);
                if (attn) {
                    pg8::Gemm g{(const bf16*)(ws + WS_XB), (const bf16*)wmix, M, 3072, D, XBP, 0, 0}; pg8::StaticOrder S; S.init(M, 3072, G, bx);
                    fill_rs(rs, (const float*)(ws + WS_PART), S, ltid(), rs + 2048, nullptr, ap->in[10] + j * 64, ap->in[11] + j * 64, attn_body::C2);
                    pg8::EpiQKV E{(bf16*)(ws + WS_ACT), rs, rs + 2048};
                    pg8::gemm_phase<pg8::EpiQKV, pg8::StaticOrder, true, true>(lds, g, S, E);
                } else {
                    pg8::Gemm g{(const bf16*)(ws + WS_XB), (const bf16*)wmix, M, 4096, D, XBP, 0, 0}; pg8::StaticOrder S; S.init(M, 4096, G, bx);
                    fill_rs(rs, (const float*)(ws + WS_PART), S, ltid(), rs + 2048, ap->in[18] + (size_t)j * 4096);
                    pg8::EpiGmlpIn E{(bf16*)(ws + WS_ACT), rs, rs + 2048, (float*)(ws + WS_STATS)};
                    pg8::gemm_phase<pg8::EpiGmlpIn, pg8::StaticOrder, true, true>(lds, g, S, E);
                }
            } else {
                if (attn) { attn_body::dattn_phase2<0>(l, (char*)lds_raw, WS_ACT, WS_O); }
                else { ArgsP ap = kargs(); LAS unsigned char* lds = (LAS unsigned char*)lds_raw; unsigned char* ws = ap->ws; const int j = l >> 1;
                    sgu_phase(lds, (bf16*)(ws + WS_ACT), (const float*)(ws + WS_STATS), (const bf16*)(ws + WS_WSB) + (size_t)j * 8 * 16384, ap->in[19] + (size_t)j * GH, ap->in[20] + (size_t)j * GH, ap->in[22] + (size_t)j * 1024, lgrid(), lbid()); }
            }
        }
        if (st + 1 >= kargs()->ph_hi) break;
        if (st == 0) cg::this_grid().sync();
        else { XcdBarrier xb_; xb_.bar = (unsigned*)(kargs()->ws + WS_CTL); xb_.x = xb_xcc_id(); xb_.st = (volatile LAS unsigned*)((LAS unsigned char*)lds_raw + MISC_OFF); xcd_barrier(xb_); }
    }
}

#ifndef MK_MULTI
#define MK_MULTI 0
#endif
extern "C" void kernel_launch(void* const* d_in, const int* in_sizes, int n_in, void* d_out, int out_size, void* d_ws, size_t ws_size, hipStream_t stream) {
    static int grid = 0;
    if (grid == 0) {
        if (n_in != 25 || in_sizes[0] != M * D || out_size != M * D || ws_size < WS_END) { fprintf(stderr, "kernel_launch: unexpected shapes: n_in %d in0 %d out %d ws %zu\n", n_in, n_in > 0 ? in_sizes[0] : -1, out_size, ws_size); grid = -1; return; }
        int dev = 0, cus = 0, per_cu = 0;
        (void)hipGetDevice(&dev); (void)hipDeviceGetAttribute(&cus, hipDeviceAttributeMultiprocessorCount, dev);
        if (hipFuncSetAttribute((const void*)fwd_kernel, hipFuncAttributeMaxDynamicSharedMemorySize, LDS_BYTES) != hipSuccess) { fprintf(stderr, "kernel_launch: hipFuncSetAttribute failed\n"); grid = -1; return; }
        if (hipOccupancyMaxActiveBlocksPerMultiprocessor(&per_cu, (const void*)fwd_kernel, NWAVES * 64, LDS_BYTES) != hipSuccess || per_cu < 1) { fprintf(stderr, "kernel_launch: occupancy query says %d\n", per_cu); per_cu = 1; }
        (void)hipGetLastError();
        grid = cus * 1;
        fprintf(stderr, "kernel_launch: grid %d (cus %d, per_cu %d)\n", grid, cus, per_cu);
    }
    if (grid < 0) return;
    (void)hipMemsetAsync((char*)d_ws + WS_CTL, 0, CTL_ZERO_BYTES, stream);
    Args a{};
    for (int i = 0; i < 25; ++i) a.in[i] = (const float*)d_in[i];
    a.out = (float*)d_out; a.ws = (unsigned char*)d_ws;
#if MK_MULTI
    for (int p = 0; p < NPHASE; ++p) { a.ph_lo = p; a.ph_hi = p + 1; hipLaunchKernelGGL(fwd_kernel, dim3(grid), dim3(NWAVES * 64), LDS_BYTES, stream, a); }
#else
    a.ph_lo = 0; a.ph_hi = NPHASE;
    void* kargs[] = {&a};
    hipError_t e = hipLaunchCooperativeKernel((const void*)fwd_kernel, dim3(grid), dim3(NWAVES * 64), kargs, LDS_BYTES, stream);
    if (e != hipSuccess) fprintf(stderr, "kernel_launch: cooperative launch failed: %s (grid %d)\n", hipGetErrorString(e), grid);
#endif
}
```
